# Optimizing an MI355X kernel written in HIP

```python
import jax, jax.numpy as jnp
from jax import lax
import numpy as np

D_MODEL = 1024
BATCH = 4
SEQ = 8192
DEPTH = 4

CTX_LEN = 256
GRID_W = 64
HEAD_DIM = 64
N_HEADS = D_MODEL // HEAD_DIM
NA_HEADS = N_HEADS // 2
WA_HEADS = N_HEADS - NA_HEADS
WA_KV_HEADS = max(1, WA_HEADS // 4)
NA_KH = 8
NA_KW = 16
WA_WINDOW = 128
WA_BLOCK = 128
D_FF = ((8 * D_MODEL // 3 + 127) // 128) * 128
ROPE_BASE = 10000.0
N_MOD = 9
MACARON_W = 0.5
NORM_EPS = 1e-6
NEG_INF = -1e30
NA_W = NA_HEADS * HEAD_DIM
WA_W = WA_HEADS * HEAD_DIM
WA_KV_W = WA_KV_HEADS * HEAD_DIM
Q_W = NA_W + WA_W
IN_W = Q_W + 2 * NA_W + 2 * WA_KV_W

kernel_name = "hybrid_natten_swa_macaron_dit_block"


def rms_norm(x, g):
    xf = x.astype(jnp.float32)
    y = xf * lax.rsqrt(jnp.mean(xf * xf, axis=-1, keepdims=True) + NORM_EPS)
    return (y * g.astype(jnp.float32)).astype(x.dtype)


def modulate(h, shift, scale):
    return h * (1 + scale) + shift


def ada_params(cond, w_ada, b_ada):
    m = jax.nn.silu(cond) @ w_ada + b_ada
    return m.reshape(m.shape[:-1] + (N_MOD, D_MODEL))


def swiglu_half_step(x, g, mod, j, w_up, w_down):
    h = modulate(rms_norm(x, g), mod[..., j, :], mod[..., j + 1, :])
    gt, up = jnp.split(h @ w_up, 2, axis=-1)
    return x + MACARON_W * mod[..., j + 2, :] * ((jax.nn.silu(gt) * up) @ w_down)


def heads(t):
    return t.reshape(t.shape[:-1] + (t.shape[-1] // HEAD_DIM, HEAD_DIM))


def axial_rope_tables(n_tokens):
    rot = HEAD_DIM // 2
    inv_freq = ROPE_BASE ** (-jnp.arange(0, rot, 2, dtype=jnp.float32) / rot)
    t = jnp.arange(n_tokens)
    row = (t // GRID_W).astype(jnp.float32)
    col = (t % GRID_W).astype(jnp.float32)
    ang = jnp.stack([row[:, None] * inv_freq, col[:, None] * inv_freq], axis=1)
    return jnp.cos(ang), jnp.sin(ang)


def apply_axial_rope(x, cos, sin):
    B, S, H, Dh = x.shape
    xr = x.reshape(B, S, H, 2, 2, Dh // 4)
    x1, x2 = xr[..., 0, :], xr[..., 1, :]
    c = cos[:, None].astype(x.dtype)
    s = sin[:, None].astype(x.dtype)
    out = jnp.stack([x1 * c - x2 * s, x2 * c + x1 * s], axis=-2)
    return out.reshape(B, S, H, Dh)


def context_self_attention(q, k, v, sink):
    B, C, Hq, Dh = q.shape
    Hkv = k.shape[2]
    G = Hq // Hkv
    qg = (q * Dh ** -0.5).reshape(B, C, Hkv, G, Dh)
    s = jnp.einsum('bqkgd,bckd->bkgqc', qg, k).astype(jnp.float32)
    if sink is not None:
        sink_col = jnp.broadcast_to(sink.astype(jnp.float32).reshape(1, Hkv, G, 1, 1), s.shape[:-1] + (1,))
        s = jnp.concatenate([s, sink_col], axis=-1)
    p = jax.nn.softmax(s, axis=-1)[..., :C].astype(v.dtype)
    out = jnp.einsum('bkgqc,bckd->bqkgd', p, v)
    return out.reshape(B, C, Hq * Dh)


def neighbourhood_attention(q, k, v, k_ctx, v_ctx, rpb):
    B, S, H, Dh = q.shape
    rows = S // GRID_W
    kh = min(NA_KH, rows)
    n_nb = kh * NA_KW
    qg = (q * Dh ** -0.5).reshape(B, rows, GRID_W, H, Dh)
    kg = k.reshape(B, rows, GRID_W, H, Dh)
    vg = v.reshape(B, rows, GRID_W, H, Dh)
    col = jnp.arange(GRID_W)
    c0 = jnp.clip(col - NA_KW // 2, 0, GRID_W - NA_KW)
    col_idx = c0[:, None] + jnp.arange(NA_KW)[None, :]
    dc = col_idx - col[:, None] + (NA_KW - 1)
    rpb32 = rpb.astype(jnp.float32)

    def one_row(r):
        r0 = jnp.clip(r - kh // 2, 0, rows - kh)
        q_r = lax.dynamic_index_in_dim(qg, r, axis=1, keepdims=False)
        k_rows = lax.dynamic_slice_in_dim(kg, r0, kh, axis=1)
        v_rows = lax.dynamic_slice_in_dim(vg, r0, kh, axis=1)
        k_win = k_rows[:, :, col_idx]
        v_win = v_rows[:, :, col_idx]
        dr = r0 + jnp.arange(kh) - r + (NA_KH - 1)
        bias = rpb32[:, dr[:, None, None], dc[None, :, :]].transpose(0, 2, 1, 3)
        s_nb = jnp.einsum('bqhd,biqjhd->bhqij', q_r, k_win).astype(jnp.float32) + bias[None]
        s_ctx = jnp.einsum('bqhd,bchd->bhqc', q_r, k_ctx).astype(jnp.float32)
        logits = jnp.concatenate([s_nb.reshape(B, H, GRID_W, n_nb), s_ctx], axis=-1)
        p = jax.nn.softmax(logits, axis=-1).astype(v.dtype)
        p_nb = p[..., :n_nb].reshape(B, H, GRID_W, kh, NA_KW)
        return (jnp.einsum('bhqij,biqjhd->bqhd', p_nb, v_win)
                + jnp.einsum('bhqc,bchd->bqhd', p[..., n_nb:], v_ctx))

    out = lax.map(one_row, jnp.arange(rows))
    return out.transpose(1, 0, 2, 3, 4).reshape(B, S, H * Dh)


def windowed_gqa_attention(q, k, v, k_ctx, v_ctx, sink):
    B, S, Hq, Dh = q.shape
    Hkv = k.shape[2]
    G = Hq // Hkv
    nb = S // WA_BLOCK
    n_loc = 3 * WA_BLOCK
    qb = (q * Dh ** -0.5).reshape(B, nb, WA_BLOCK, Hkv, G, Dh)
    pad = ((0, 0), (WA_BLOCK, WA_BLOCK), (0, 0), (0, 0))
    kp = jnp.pad(k, pad)
    vp = jnp.pad(v, pad)
    q_off = jnp.arange(WA_BLOCK)
    k_off = jnp.arange(n_loc) - WA_BLOCK
    band = jnp.abs(k_off[None, :] - q_off[:, None]) <= WA_WINDOW
    sink_col = jnp.broadcast_to(sink.astype(jnp.float32).reshape(1, Hkv, G, 1, 1), (B, Hkv, G, WA_BLOCK, 1))

    def one_block(i):
        q_i = lax.dynamic_index_in_dim(qb, i, axis=1, keepdims=False)
        k_i = lax.dynamic_slice_in_dim(kp, i * WA_BLOCK, n_loc, axis=1)
        v_i = lax.dynamic_slice_in_dim(vp, i * WA_BLOCK, n_loc, axis=1)
        k_pos = i * WA_BLOCK + k_off
        valid = band & ((k_pos >= 0) & (k_pos < S))[None, :]
        s_loc = jnp.einsum('bqkgd,bjkd->bkgqj', q_i, k_i).astype(jnp.float32)
        s_loc = jnp.where(valid, s_loc, NEG_INF)
        s_ctx = jnp.einsum('bqkgd,bckd->bkgqc', q_i, k_ctx).astype(jnp.float32)
        p = jax.nn.softmax(jnp.concatenate([s_loc, s_ctx, sink_col], axis=-1), axis=-1).astype(v.dtype)
        out = (jnp.einsum('bkgqj,bjkd->bqkgd', p[..., :n_loc], v_i)
               + jnp.einsum('bkgqc,bckd->bqkgd', p[..., n_loc:-1], v_ctx))
        return out.reshape(B, WA_BLOCK, Hq * Dh)

    out = lax.map(one_block, jnp.arange(nb))
    return out.transpose(1, 0, 2, 3).reshape(B, S, Hq * Dh)


def split_kv(p):
    o1, o2, o3 = NA_W, 2 * NA_W, 2 * NA_W + WA_KV_W
    return p[..., :o1], p[..., o1:o2], p[..., o2:o3], p[..., o3:]


def setup_inputs(seed: int = 0) -> dict:
    key = jax.random.key(seed)
    ks = jax.random.split(key, 14)
    f32 = jnp.float32

    def nrm(k, shape, scale):
        return jax.random.normal(k, shape, f32) * scale

    return {
        "x": nrm(ks[0], (BATCH, SEQ, D_MODEL), 1.0),
        "c": nrm(ks[1], (BATCH, D_MODEL), 1.0),
        "ctx": nrm(ks[2], (BATCH, CTX_LEN, D_MODEL), 1.0),
        "c_ctx": nrm(ks[3], (D_MODEL,), 1.0),
        "w_ada": nrm(ks[4], (DEPTH, D_MODEL, N_MOD * D_MODEL), 0.5 * D_MODEL ** -0.5),
        "b_ada": nrm(ks[5], (DEPTH, N_MOD * D_MODEL), 0.02),
        "norm_g": 1.0 + nrm(ks[6], (DEPTH, 3, D_MODEL), 0.02),
        "w_ffn_up": nrm(ks[7], (DEPTH, 2, D_MODEL, 2 * D_FF), D_MODEL ** -0.5),
        "w_ffn_down": nrm(ks[8], (DEPTH, 2, D_FF, D_MODEL), D_FF ** -0.5),
        "w_in": nrm(ks[9], (DEPTH, D_MODEL, IN_W), D_MODEL ** -0.5),
        "w_out": nrm(ks[10], (DEPTH, Q_W, D_MODEL), Q_W ** -0.5),
        "qk_norm_g": 1.0 + nrm(ks[11], (DEPTH, 4, HEAD_DIM), 0.02),
        "na_rpb": nrm(ks[12], (DEPTH, NA_HEADS, 2 * NA_KH - 1, 2 * NA_KW - 1), 0.1),
        "wa_sink": nrm(ks[13], (DEPTH, WA_HEADS), 0.5),
    }


def reference(x, c, ctx, c_ctx, w_ada, b_ada, norm_g, w_ffn_up, w_ffn_down, w_in, w_out,
              qk_norm_g, na_rpb, wa_sink):
    S = x.shape[1]
    cos, sin = axial_rope_tables(S)
    h_ctx = ctx
    for l in range(DEPTH):
        last = l == DEPTH - 1
        mod_x = ada_params(c, w_ada[l], b_ada[l])[:, None]
        mod_c = ada_params(c_ctx, w_ada[l], b_ada[l])[None, None]

        x = swiglu_half_step(x, norm_g[l, 0], mod_x, 0, w_ffn_up[l, 0], w_ffn_down[l, 0])
        h_ctx = swiglu_half_step(h_ctx, norm_g[l, 0], mod_c, 0, w_ffn_up[l, 0], w_ffn_down[l, 0])

        hx = modulate(rms_norm(x, norm_g[l, 1]), mod_x[..., 3, :], mod_x[..., 4, :])
        hc = modulate(rms_norm(h_ctx, norm_g[l, 1]), mod_c[..., 3, :], mod_c[..., 4, :])
        px = hx @ w_in[l]
        pc = hc @ (w_in[l, :, Q_W:] if last else w_in[l])
        pc_kv = pc[..., -(IN_W - Q_W):]

        qa = rms_norm(heads(px[..., :NA_W]), qk_norm_g[l, 0])
        qb = rms_norm(heads(px[..., NA_W:Q_W]), qk_norm_g[l, 2])
        ka, va, kb, vb = split_kv(px[..., Q_W:])
        ka = rms_norm(heads(ka), qk_norm_g[l, 1])
        kb = rms_norm(heads(kb), qk_norm_g[l, 3])
        va, vb = heads(va), heads(vb)
        qb = apply_axial_rope(qb, cos, sin)
        kb = apply_axial_rope(kb, cos, sin)

        ka_c, va_c, kb_c, vb_c = split_kv(pc_kv)
        ka_c = rms_norm(heads(ka_c), qk_norm_g[l, 1])
        kb_c = rms_norm(heads(kb_c), qk_norm_g[l, 3])
        va_c, vb_c = heads(va_c), heads(vb_c)

        out_a = neighbourhood_attention(qa, ka, va, ka_c, va_c, na_rpb[l])
        out_b = windowed_gqa_attention(qb, kb, vb, kb_c, vb_c, wa_sink[l])
        x = x + mod_x[..., 5, :] * (jnp.concatenate([out_a, out_b], axis=-1) @ w_out[l])

        if not last:
            qa_c = rms_norm(heads(pc[..., :NA_W]), qk_norm_g[l, 0])
            qb_c = rms_norm(heads(pc[..., NA_W:Q_W]), qk_norm_g[l, 2])
            out_a_c = context_self_attention(qa_c, ka_c, va_c, None)
            out_b_c = context_self_attention(qb_c, kb_c, vb_c, wa_sink[l])
            h_ctx = h_ctx + mod_c[..., 5, :] * (jnp.concatenate([out_a_c, out_b_c], axis=-1) @ w_out[l])

        x = swiglu_half_step(x, norm_g[l, 2], mod_x, 6, w_ffn_up[l, 1], w_ffn_down[l, 1])
        if not last:
            h_ctx = swiglu_half_step(h_ctx, norm_g[l, 2], mod_c, 6, w_ffn_up[l, 1], w_ffn_down[l, 1])
    return x
```

```cpp
#include <hip/hip_runtime.h>
#include <hip/hip_cooperative_groups.h>
#include <cstdio>
#include <cstdint>
namespace cg = cooperative_groups;
namespace pg8 {
#define PG8_LAS __attribute__((address_space(3)))
typedef unsigned short bf16_t;
typedef short bf16x8 __attribute__((ext_vector_type(8)));
typedef float f32x4 __attribute__((ext_vector_type(4)));
typedef unsigned u32x4 __attribute__((ext_vector_type(4)));
constexpr int BM = 256, BK = 64, HALF = 128, HTB = HALF * BK * 2  , STAGE_BYTES = 8 * HTB, NXCD = 8, WGM = 8;

__host__ __device__ __forceinline__ int lds_byte(int r, int c) { const int st = (r >> 4) * 2 + (c >> 5), rr = r & 15, cc = c & 31, ob = rr * 64 + cc * 2; return st * 1024 + (ob ^ (((ob >> 9) & 1) << 5)); }
__host__ __device__ __forceinline__ void stage_rc(int b, int& R, int& C) { const int st = b / 1024, sb = b % 1024, swz = sb ^ (((sb >> 9) & 1) << 5); R = (st >> 1) * 16 + swz / 64; C = (st & 1) * 32 + (swz % 64) / 2; }
__host__ __device__ __forceinline__ int perm32(int rho) { const int n = rho >> 4, i = rho & 15; return 8 * (i >> 2) + 4 * n + (i & 3); }

struct Unit { int pm, pn, kt0, nt; };
struct Gemm { const bf16_t* A; const bf16_t* Bt; int M, N, K; };

struct StaticOrder {
    int nM, nN, nwg, G, c, ntk;
    __host__ __device__ void init(int M, int N, int G_, int c_, int ntk_) { nM = M / BM; nN = N / BM; nwg = nM * nN; G = G_; c = c_; ntk = ntk_; }
    __host__ __device__ bool next(int i, Unit& u) const {
        const long L = (long)i * G + c; if (L >= nwg) { u.pm = 0; u.pn = 0; u.kt0 = 0; u.nt = ntk; return false; }
        int wgid = (int)L; { const int q = nwg / NXCD, r = nwg % NXCD, xcd = wgid % NXCD, off = wgid / NXCD; wgid = (xcd < r ? xcd * (q + 1) : r * (q + 1) + (xcd - r) * q) + off; }
        const int nig = WGM * nN, gid = wgid / nig, fm = gid * WGM, gsz = (nM - fm) < WGM ? (nM - fm) : WGM;
        u.pm = fm + ((wgid % nig) % gsz); u.pn = (wgid % nig) / gsz; u.kt0 = 0; u.nt = ntk; return true;
    }
    __device__ __forceinline__ void a_ready(const Unit&) const {}
    __device__ __forceinline__ void done(const Unit&) const {}
};

__device__ __forceinline__ unsigned cvt_pk_bf16(float lo, float hi) { unsigned r; asm volatile("v_cvt_pk_bf16_f32 %0, %1, %2" : "=v"(r) : "v"(lo), "v"(hi)); return r; }
__device__ __forceinline__ unsigned rnd6pk(unsigned w) { return (w + ((w >> 1) & 0x00010001u)) & 0xfffefffeu; }
typedef float f32x2 __attribute__((ext_vector_type(2)));

struct ResOrder {
    StaticOrder lat; int rounds, nctx, nsplit, G, c;
    __host__ __device__ void init(int G_, int c_, int ntk, int nsplit_) { lat.init(32768, 1024, G_, c_, ntk); G = G_; c = c_; nsplit = nsplit_; nctx = 16 * nsplit_; rounds = (lat.nwg + G_ - 1) / G_; }
    __host__ __device__ bool next(int i, Unit& u) const {
        Unit v; v.pm = 0; v.pn = 0; v.kt0 = 0; v.nt = 2; bool ok;
        if (i < rounds) ok = lat.next(i, v);
        else { const int j = (i - rounds) * G + c; ok = j < nctx; const int jj = ok ? j : 0, ns = nsplit > 0 ? nsplit : 1; const int t = jj / ns, s = jj % ns; v.pm = 128 + (t >> 2); v.pn = t & 3; v.kt0 = 4 * s; v.nt = 4; }
        u.pm = v.pm; u.pn = v.pn; u.kt0 = v.kt0; u.nt = v.nt; return ok;
    }
    __device__ __forceinline__ void a_ready(const Unit&) const {}
    __device__ __forceinline__ void done(const Unit&) const {}
};
typedef unsigned u32x2 __attribute__((ext_vector_type(2)));
constexpr int E_DM = 1024, E_DFF = 2816, E_SEQ = 8192, E_MLAT = 32768, E_CTXL = 256, E_MODW = 9216;

struct EpiUp {
    static constexpr bool PERM = true, AFTER_DRAIN = false, PREFETCH = true;
    bf16_t* ACT; const float* R; const float* sW; PG8_LAS unsigned char* xl;
    __device__ __forceinline__ void prefetch(const Unit& u, int par, int wid, int lane) const {
        const int cond = u.pm < 128 ? (u.pm >> 5) : 4;
        const float* gp = wid < 4 ? R + (size_t)u.pm * BM + wid * 64 + lane : sW + cond * (2 * E_DFF) + u.pn * BM + (wid - 4) * 64 + lane;
        __builtin_amdgcn_global_load_lds((const unsigned*)gp, (PG8_LAS unsigned*)(xl + par * 2048 + wid * 256), 4, 0, 0);
    }
    __device__ __forceinline__ void operator()(const f32x4 (&acc)[2][2][4][2], const Unit& u, int wr, int wc, int fr_, int fq_, int par) const {
        int fr = fr_, fq = fq_; asm volatile("" : "+v"(fr), "+v"(fq));
        const int row0 = u.pm * BM + wr * 64 + fr, col0 = u.pn * 128 + wc * 32 + 8 * fq;
        const PG8_LAS float* rl = (const PG8_LAS float*)(xl + par * 2048) + wr * 64 + fr;
        const PG8_LAS float* sl = (const PG8_LAS float*)(xl + par * 2048 + 1024) + wc * 32 + 8 * fq;
        f32x4 sg[2], su[2];
#pragma unroll
        for (int n = 0; n < 2; ++n) { sg[n] = *(const PG8_LAS f32x4*)(sl + 4 * n); su[n] = *(const PG8_LAS f32x4*)(sl + HALF + 4 * n); }
#pragma unroll
        for (int ai = 0; ai < 2; ++ai) {
#pragma unroll
            for (int m = 0; m < 4; ++m) {
                bf16_t* rowp = ACT + (size_t)(row0 + ai * HALF + m * 16) * E_DFF + col0;
                const float r = rl[ai * HALF + m * 16];
                float a[8];
#pragma unroll
                for (int n = 0; n < 2; ++n)
#pragma unroll
                    for (int e = 0; e < 4; ++e) { const float g = r * acc[ai][0][m][n][e] + sg[n][e], up = r * acc[ai][1][m][n][e] + su[n][e];
                        a[n * 4 + e] = g * __builtin_amdgcn_rcpf(1.0f + __expf(-g)) * up; }
                u32x4 w; w.x = cvt_pk_bf16(a[0], a[1]); w.y = cvt_pk_bf16(a[2], a[3]); w.z = cvt_pk_bf16(a[4], a[5]); w.w = cvt_pk_bf16(a[6], a[7]);
                w.x = rnd6pk(w.x); w.y = rnd6pk(w.y); w.z = rnd6pk(w.z); w.w = rnd6pk(w.w);
                *(u32x4*)rowp = w;
            }
        }
    }
};

struct EpiRes {
    static constexpr bool PERM = false, AFTER_DRAIN = false, PREFETCH = false;
    const float* src_lat; float* dst_lat; float* dst_ctx; const float* modv; bf16_t* XGa; bf16_t* XGb; float* SS; const float* gnext; const float* sclnext; int flags;
    __device__ __forceinline__ void operator()(const f32x4 (&acc)[2][2][4][2], const Unit& u, int wr, int wc, int fr_, int fq_, int) const {
        int fr = fr_, fq = fq_; asm volatile("" : "+v"(fr), "+v"(fq));
        const bool lat = u.pm < 128; const int cond = lat ? (u.pm >> 5) : 4;
        const float coef0 = (flags & 4) ? 1.0f : 0.5f;
        const float* mv = modv + cond * E_MODW;
        const size_t tb = lat ? (size_t)u.pm * BM * E_DM : (size_t)(u.pm - 128) * BM * E_DM;
        const float* src = src_lat + tb; float* dst = (lat ? dst_lat : dst_ctx + (size_t)(u.kt0 >> 2) * (1024 * E_DM)) + tb;
        const int col0 = u.pn * BM + wc * 32 + 4 * fq;
        f32x4 g[2][2];
#pragma unroll
        for (int bj = 0; bj < 2; ++bj)
#pragma unroll
            for (int n = 0; n < 2; ++n) g[bj][n] = *(const f32x4*)(mv + col0 + bj * HALF + n * 16) * coef0;
        const bool emit = lat && (flags & 1) != 0; bf16_t* XG = (flags & 2) ? XGb : XGa;
        f32x4 gm[2][2];
        if (emit) {
#pragma unroll
            for (int bj = 0; bj < 2; ++bj)
#pragma unroll
                for (int n = 0; n < 2; ++n) gm[bj][n] = *(const f32x4*)(gnext + col0 + bj * HALF + n * 16) * (1.0f + *(const f32x4*)(sclnext + cond * E_MODW + col0 + bj * HALF + n * 16));
        }
#pragma unroll
        for (int ai = 0; ai < 2; ++ai)
#pragma unroll
            for (int m = 0; m < 4; ++m) { const size_t off = (size_t)(ai * HALF + wr * 64 + m * 16 + fr) * E_DM + col0; float ss = 0.f;
#pragma unroll
                for (int bj = 0; bj < 2; ++bj)
#pragma unroll
                    for (int n = 0; n < 2; ++n) {
                        if (lat) { const f32x4 s = *(const f32x4*)(src + off + bj * HALF + n * 16);
                            const f32x4 o = s + g[bj][n] * acc[ai][bj][m][n];
                            *(f32x4*)(dst + off + bj * HALF + n * 16) = o;
                            if (emit) { const f32x4 q = o * o; ss += (q[0] + q[1]) + (q[2] + q[3]); const f32x4 xg = o * gm[bj][n];
                                u32x2 w; w.x = rnd6pk(cvt_pk_bf16(xg[0], xg[1])); w.y = rnd6pk(cvt_pk_bf16(xg[2], xg[3])); *(u32x2*)(XG + tb + off + bj * HALF + n * 16) = w; } }
                        else *(f32x4*)(dst + off + bj * HALF + n * 16) = g[bj][n] * acc[ai][bj][m][n];
                    }
                if (emit) { ss += __shfl_xor(ss, 16); ss += __shfl_xor(ss, 32); if (fq == 0) SS[(size_t)(u.pm * BM + ai * HALF + wr * 64 + m * 16 + fr) * 16 + u.pn * 4 + wc] = ss; }
                if (m & 1) asm volatile("" ::: "memory");
            }
    }
};

struct EpiQKV {
    static constexpr bool PERM = false, AFTER_DRAIN = false, PREFETCH = true;
    bf16_t* Q; bf16_t* Kb; bf16_t* KC; bf16_t* VT; bf16_t* VTC; const float* qkg; const float* rope; const float* R; const float* sW; PG8_LAS unsigned char* xl;
    __device__ __forceinline__ void prefetch(const Unit& u, int par, int wid, int lane) const {
        const int cond = u.pm < 128 ? (u.pm >> 5) : 4;
        const float* gp = wid < 4 ? R + (size_t)u.pm * BM + wid * 64 + lane : sW + cond * (2 * E_DFF) + u.pn * BM + (wid - 4) * 64 + lane;
        __builtin_amdgcn_global_load_lds((const unsigned*)gp, (PG8_LAS unsigned*)(xl + par * 2048 + wid * 256), 4, 0, 0);
    }
    __device__ __forceinline__ void operator()(const f32x4 (&acc)[2][2][4][2], const Unit& u, int wr, int wc, int fr_, int fq_, int par) const {
        int fr = fr_, fq = fq_; asm volatile("" : "+v"(fr), "+v"(fq));
        const int head = u.pn * 4 + wc;
        const int type = head < 8 ? 0 : head < 16 ? 1 : head < 24 ? 2 : head < 32 ? 3 : head < 34 ? 4 : 5;
        const bool isv = (type == 3 || type == 5), lat = u.pm < 128;
        const PG8_LAS float* rl = (const PG8_LAS float*)(xl + par * 2048) + wr * 64 + fr;
        const PG8_LAS float* sl = (const PG8_LAS float*)(xl + par * 2048 + 1024) + wc * 32 + 4 * fq;
        f32x4 sw4[2][2];
#pragma unroll
        for (int bj = 0; bj < 2; ++bj)
#pragma unroll
            for (int n = 0; n < 2; ++n) sw4[bj][n] = *(const PG8_LAS f32x4*)(sl + bj * HALF + n * 16);
        if (!isv) {
            const int gi = type == 0 ? 0 : type == 2 ? 1 : type == 1 ? 2 : 3;
            const bool dorope = (type == 1 || type == 4) && lat;
            const float qs = type <= 1 ? 0.125f * 1.4426950408889634f : 1.0f;
            f32x4 g[2][2];
#pragma unroll
            for (int bj = 0; bj < 2; ++bj)
#pragma unroll
                for (int n = 0; n < 2; ++n) g[bj][n] = *(const f32x4*)(qkg + gi * 64 + 32 * bj + 16 * n + 4 * fq);
            const int kh = type == 2 ? head - 16 : 8 + head - 32;
#pragma unroll
            for (int ai = 0; ai < 2; ++ai) {
#pragma unroll
                for (int m = 0; m < 4; ++m) {
                    const int row = u.pm * BM + ai * HALF + wr * 64 + m * 16 + fr;
                    f32x4 v[2][2]; float ss = 0.f;
                    const float rr = rl[ai * HALF + m * 16];
#pragma unroll
                    for (int bj = 0; bj < 2; ++bj)
#pragma unroll
                        for (int n = 0; n < 2; ++n) { v[bj][n] = rr * acc[ai][bj][m][n] + sw4[bj][n]; const f32x4 q = v[bj][n] * v[bj][n]; ss += (q[0] + q[1]) + (q[2] + q[3]); }
                    ss += __shfl_xor(ss, 16); ss += __shfl_xor(ss, 32);
                    const float r = rsqrtf(ss * (1.0f / 64.0f) + 1e-6f);
#pragma unroll
                    for (int bj = 0; bj < 2; ++bj)
#pragma unroll
                        for (int n = 0; n < 2; ++n) v[bj][n] = v[bj][n] * r * g[bj][n];
                    if (dorope) {
                        const int t = row & (E_SEQ - 1);
#pragma unroll
                        for (int bj = 0; bj < 2; ++bj) { const int pos = bj ? 128 + (t & 63) : (t >> 6);
                            const f32x4 c4 = *(const f32x4*)(rope + pos * 16 + 4 * fq), s4 = *(const f32x4*)(rope + 3072 + pos * 16 + 4 * fq);
                            const f32x4 x1 = v[bj][0], x2 = v[bj][1]; v[bj][0] = x1 * c4 - x2 * s4; v[bj][1] = x2 * c4 + x1 * s4; }
                    }
                    bf16_t* rp;
                    if (type <= 1) rp = Q + (size_t)row * 1024 + head * 64 + 4 * fq;
                    else if (lat) { const int b = row >> 13, t = row & (E_SEQ - 1); rp = Kb + ((size_t)(b * 10 + kh) * 128 + (t >> 6)) * 4096 + ((t >> 5) & 1) * 2048 + (((fq >> 1) << 5) | (t & 31)) * 8 + (fq & 1) * 4; }
                    else { const int rc = row - E_MLAT, b = rc >> 8, t = rc & 255; rp = KC + ((size_t)(b * 10 + kh) * 4 + (t >> 6)) * 4096 + ((t >> 5) & 1) * 2048 + (((fq >> 1) << 5) | (t & 31)) * 8 + (fq & 1) * 4; }
                    const int cstep = type <= 1 ? 16 : 512;
#pragma unroll
                    for (int bj = 0; bj < 2; ++bj)
#pragma unroll
                        for (int n = 0; n < 2; ++n) { const f32x4 o = v[bj][n] * qs; u32x2 w; w.x = cvt_pk_bf16(o[0], o[1]); w.y = cvt_pk_bf16(o[2], o[3]);
                            *(u32x2*)(rp + (2 * bj + n) * cstep) = w; }
                }
            }
        } else {
            const int hv = type == 3 ? head - 24 : 8 + head - 34;
#pragma unroll
            for (int ai = 0; ai < 2; ++ai) {
#pragma unroll
                for (int m = 0; m < 4; ++m) {
                    const int row = u.pm * BM + ai * HALF + wr * 64 + m * 16 + fr;
                    const float rr = rl[ai * HALF + m * 16];
                    bf16_t* bp; constexpr size_t pitch = 8; int t;
                    if (lat) { const int b = row >> 13; t = row & (E_SEQ - 1); bp = VT + ((size_t)(b * 10 + hv) * 128 + (t >> 6)) * 4096; }
                    else { const int rc = row - E_MLAT, b = rc >> 8; t = rc & 255; bp = VTC + ((size_t)(b * 10 + hv) * 4 + (t >> 6)) * 4096; }
                    bp += ((t >> 4) & 3) * 512 + ((t >> 2) & 1) * 256 + ((t >> 3) & 1) * 4 + (t & 3);
#pragma unroll
                    for (int bj = 0; bj < 2; ++bj)
#pragma unroll
                        for (int n = 0; n < 2; ++n) { const f32x4 o = rr * acc[ai][bj][m][n] + sw4[bj][n]; const unsigned w0 = cvt_pk_bf16(o[0], o[1]), w1 = cvt_pk_bf16(o[2], o[3]);
                            bf16_t* dp = bp + bj * 2048 + (size_t)(16 * n + 4 * fq) * pitch;
                            dp[0] = (bf16_t)(w0 & 0xffffu); dp[pitch] = (bf16_t)(w0 >> 16); dp[2 * pitch] = (bf16_t)(w1 & 0xffffu); dp[3 * pitch] = (bf16_t)(w1 >> 16); }
                }
            }
        }
    }
};

template <class Epi, class Sched, bool ALIGN_EPI = false, bool SP2 = false>
__device__ __forceinline__ void gemm_phase(PG8_LAS unsigned char* lds, const Gemm g, const Sched& S, const Epi& E) {
    int tid_ = threadIdx.x; asm volatile("" : "+v"(tid_));
    const int tid = tid_, wid = __builtin_amdgcn_readfirstlane(tid >> 6), lane = tid & 63, wr = wid >> 2, wc = wid & 3, fr = lane & 15, fq = lane >> 4;
    const int K = g.K;
    unsigned voffA[2], voffB[2];
#pragma unroll
    for (int i = 0; i < 2; ++i) { int R, C; stage_rc(tid * 16 + i * 8192, R, C); const int Rb = Epi::PERM ? ((R & ~31) + perm32(R & 31)) : R;
        voffA[i] = (unsigned)(R * K + C) * 2u; voffB[i] = (unsigned)(Rb * K + C) * 2u; }
    const size_t kstep = (size_t)(BK * 2);
    const size_t hstep = (size_t)HALF * K * 2;
    const size_t tstep = 2 * hstep;
    const unsigned ldsw = (unsigned)wid * 1024u;
    const int aoff = lds_byte(wr * 64 + fr, fq * 8), boff = lds_byte(wc * 32 + fr, fq * 8);
#define PG8_SA(b, h) (((b) * 2 + (h)) * HTB)
#define PG8_SB(b, h) ((4 + (b) * 2 + (h)) * HTB)
#define PG8_STAGE(bufoff, gbase, voff) do { _Pragma("unroll") for (int _i = 0; _i < 2; ++_i) \
        __builtin_amdgcn_global_load_lds((const unsigned*)((const char*)(gbase) + (voff)[_i]), (PG8_LAS unsigned*)(lds + (bufoff) + ldsw + _i * 8192), 16, 0, 0); } while (0)
#define PG8_LDA(dst, b, h) do { _Pragma("unroll") for (int m = 0; m < 4; ++m) _Pragma("unroll") for (int k = 0; k < 2; ++k) dst[m][k] = *(const PG8_LAS bf16x8*)(lds + PG8_SA(b, h) + aoff + m * 2048 + k * 1024); } while (0)
#define PG8_LDB(dst, b, h) do { _Pragma("unroll") for (int n = 0; n < 2; ++n) _Pragma("unroll") for (int k = 0; k < 2; ++k) dst[n][k] = *(const PG8_LAS bf16x8*)(lds + PG8_SB(b, h) + boff + n * 2048 + k * 1024); } while (0)
#define PG8_MMA(ai, bj, At, Bt) do { __builtin_amdgcn_s_setprio(1); _Pragma("unroll") for (int m = 0; m < 4; ++m) _Pragma("unroll") for (int n = 0; n < 2; ++n) _Pragma("unroll") for (int k = 0; k < 2; ++k) \
        acc[ai][bj][m][n] = __builtin_amdgcn_mfma_f32_16x16x32_bf16(Bt[n][k], At[m][k], acc[ai][bj][m][n], 0, 0, 0); __builtin_amdgcn_s_setprio(0); } while (0)
#define PG8_WAIT_V(n) asm volatile("s_waitcnt vmcnt(" #n ")" ::: "memory")
#define PG8_WAIT_L(n) asm volatile("s_waitcnt lgkmcnt(" #n ")" ::: "memory")
#define PG8_BAR __builtin_amdgcn_s_barrier()
#define PG8_SCHED __builtin_amdgcn_sched_barrier(0)
    Unit cur{0, 0, 0, 2}, nxt{0, 0, 0, 2}; int ui = 0;
    if (!S.next(0, cur)) return;
    if constexpr (Epi::PREFETCH) E.prefetch(cur, 0, wid, lane);
    f32x4 acc[2][2][4][2];
#pragma unroll
    for (int a = 0; a < 2; ++a)
#pragma unroll
        for (int b = 0; b < 2; ++b)
#pragma unroll
            for (int m = 0; m < 4; ++m)
#pragma unroll
                for (int n = 0; n < 2; ++n) acc[a][b][m][n] = (f32x4){0.f, 0.f, 0.f, 0.f};
    bf16x8 At[4][2], B0[2][2], B1[2][2];
    const char* cA = (const char*)g.A + (size_t)cur.pm * tstep + (size_t)cur.kt0 * kstep; const char* cB = (const char*)g.Bt + (size_t)cur.pn * tstep + (size_t)cur.kt0 * kstep;
    S.a_ready(cur);
    if constexpr (SP2) {
        PG8_STAGE(PG8_SB(0, 0), cB, voffB); PG8_STAGE(PG8_SB(0, 1), cB + hstep, voffB); PG8_STAGE(PG8_SA(0, 0), cA, voffA); PG8_STAGE(PG8_SA(0, 1), cA + hstep, voffA);
        if (wr == 1) PG8_BAR;
        PG8_WAIT_V(2); PG8_BAR;
        PG8_STAGE(PG8_SB(1, 0), cB + kstep, voffB); PG8_STAGE(PG8_SA(1, 0), cA + kstep, voffA); PG8_STAGE(PG8_SB(1, 1), cB + hstep + kstep, voffB);
        PG8_WAIT_V(6); PG8_BAR;
    } else {
        PG8_STAGE(PG8_SB(0, 0), cB, voffB); PG8_STAGE(PG8_SA(0, 0), cA, voffA); PG8_STAGE(PG8_SB(0, 1), cB + hstep, voffB); PG8_STAGE(PG8_SA(0, 1), cA + hstep, voffA);
        if (wr == 1) PG8_BAR;
        PG8_WAIT_V(4); PG8_BAR;
        PG8_STAGE(PG8_SB(1, 0), cB + kstep, voffB); PG8_STAGE(PG8_SA(1, 0), cA + kstep, voffA); PG8_STAGE(PG8_SB(1, 1), cB + hstep + kstep, voffB);
        PG8_WAIT_V(6); PG8_BAR;
    }
    for (;;) {
        const bool has_next = S.next(ui + 1, nxt);
        const char* nA = has_next ? (const char*)g.A + (size_t)nxt.pm * tstep + (size_t)nxt.kt0 * kstep : cA; const char* nB = has_next ? (const char*)g.Bt + (size_t)nxt.pn * tstep + (size_t)nxt.kt0 * kstep : cB;
        const int nt = cur.nt;
        for (int t = 0; t < nt; t += 2) {
            const bool last = (t == nt - 2);
            const char* a1 = cA + (size_t)(t + 1) * kstep;
            const char* a2 = last ? nA : cA + (size_t)(t + 2) * kstep; const char* b2 = last ? nB : cB + (size_t)(t + 2) * kstep;
            const char* a3 = a2 + kstep; const char* b3 = b2 + kstep;
            if (last && has_next) S.a_ready(nxt);
            if constexpr (SP2) {
            PG8_LDB(B0, 0, 0); PG8_LDB(B1, 0, 1); PG8_SCHED; PG8_LDA(At, 0, 0); PG8_STAGE(PG8_SA(1, 1), a1 + hstep, voffA);
            PG8_WAIT_V(8); PG8_WAIT_L(0); PG8_BAR; PG8_MMA(0, 0, At, B0); PG8_MMA(0, 1, At, B1); PG8_BAR; PG8_SCHED;
            PG8_LDA(At, 0, 1); PG8_STAGE(PG8_SB(0, 0), b2, voffB); PG8_STAGE(PG8_SB(0, 1), b2 + hstep, voffB); PG8_STAGE(PG8_SA(0, 0), a2, voffA);
            PG8_WAIT_V(8); PG8_WAIT_L(0); PG8_BAR; PG8_MMA(1, 0, At, B0); PG8_MMA(1, 1, At, B1); PG8_BAR; PG8_SCHED;
            PG8_LDB(B0, 1, 0); PG8_LDB(B1, 1, 1); PG8_SCHED; PG8_LDA(At, 1, 0); PG8_STAGE(PG8_SA(0, 1), a2 + hstep, voffA);
            PG8_WAIT_V(8); PG8_WAIT_L(0); PG8_BAR; PG8_MMA(0, 0, At, B0); PG8_MMA(0, 1, At, B1); PG8_BAR; PG8_SCHED;
            PG8_LDA(At, 1, 1); PG8_STAGE(PG8_SB(1, 0), b3, voffB); PG8_STAGE(PG8_SB(1, 1), b3 + hstep, voffB); PG8_STAGE(PG8_SA(1, 0), a3, voffA);
            PG8_WAIT_V(8); PG8_WAIT_L(0); PG8_BAR; PG8_MMA(1, 0, At, B0); PG8_MMA(1, 1, At, B1); PG8_BAR; PG8_SCHED;
            } else {
            PG8_LDB(B0, 0, 0); PG8_SCHED; PG8_LDA(At, 0, 0); PG8_STAGE(PG8_SA(1, 1), a1 + hstep, voffA);
            PG8_WAIT_L(8); PG8_BAR; PG8_WAIT_L(0); PG8_MMA(0, 0, At, B0); PG8_BAR; PG8_SCHED;
            PG8_LDB(B1, 0, 1); PG8_STAGE(PG8_SB(0, 0), b2, voffB);
            PG8_BAR; PG8_WAIT_L(0); PG8_MMA(0, 1, At, B1); PG8_BAR;
            PG8_LDA(At, 0, 1); PG8_STAGE(PG8_SA(0, 0), a2, voffA);
            PG8_BAR; PG8_WAIT_L(0); PG8_MMA(1, 0, At, B0); PG8_BAR; PG8_SCHED;
            PG8_STAGE(PG8_SB(0, 1), b2 + hstep, voffB);
            PG8_WAIT_V(6); PG8_BAR; PG8_MMA(1, 1, At, B1); PG8_BAR;
            PG8_LDB(B0, 1, 0); PG8_SCHED; PG8_LDA(At, 1, 0); PG8_STAGE(PG8_SA(0, 1), a2 + hstep, voffA);
            PG8_WAIT_L(8); PG8_BAR; PG8_WAIT_L(0); PG8_MMA(0, 0, At, B0); PG8_BAR; PG8_SCHED;
            PG8_LDB(B1, 1, 1); PG8_STAGE(PG8_SB(1, 0), b3, voffB);
            PG8_BAR; PG8_WAIT_L(0); PG8_MMA(0, 1, At, B1); PG8_BAR;
            PG8_LDA(At, 1, 1); PG8_STAGE(PG8_SA(1, 0), a3, voffA);
            PG8_BAR; PG8_WAIT_L(0); PG8_MMA(1, 0, At, B0); PG8_BAR; PG8_SCHED;
            PG8_STAGE(PG8_SB(1, 1), b3 + hstep, voffB);
            PG8_WAIT_V(6); PG8_BAR; PG8_MMA(1, 1, At, B1); PG8_BAR;
            }
        }
        if constexpr (ALIGN_EPI) { if (wr == 0) PG8_BAR; }
        if constexpr (!Epi::AFTER_DRAIN) { E(acc, cur, wr, wc, fr, fq, ui & 1); S.done(cur); }
        if (!has_next) break;
#pragma unroll
        for (int a = 0; a < 2; ++a)
#pragma unroll
            for (int b = 0; b < 2; ++b)
#pragma unroll
                for (int m = 0; m < 4; ++m)
#pragma unroll
                    for (int n = 0; n < 2; ++n) acc[a][b][m][n] = (f32x4){0.f, 0.f, 0.f, 0.f};
        cur = nxt; cA = nA; cB = nB; ++ui;
        if constexpr (Epi::PREFETCH) E.prefetch(cur, ui & 1, wid, lane);
        if constexpr (ALIGN_EPI) { if (wr == 1) PG8_BAR; }
    }
    PG8_WAIT_V(0);
    if constexpr (!ALIGN_EPI) { if (wr == 0) PG8_BAR; }
    PG8_BAR;
    if constexpr (Epi::AFTER_DRAIN) { E.fused(acc, cur, wr, wc, fr, fq, lds, wid, lane); S.done(cur); }
#undef PG8_SA
#undef PG8_SB
#undef PG8_STAGE
#undef PG8_LDA
#undef PG8_LDB
#undef PG8_MMA
#undef PG8_WAIT_V
#undef PG8_WAIT_L
#undef PG8_BAR
#undef PG8_SCHED
}
}

#define LAS __attribute__((address_space(3)))
typedef unsigned short bf16;
typedef float f32x4 __attribute__((ext_vector_type(4)));
typedef float f32x16 __attribute__((ext_vector_type(16)));
typedef short bf16x8 __attribute__((ext_vector_type(8)));
typedef short s16x4 __attribute__((ext_vector_type(4)));
typedef unsigned v4u __attribute__((ext_vector_type(4)));
typedef unsigned v2u __attribute__((ext_vector_type(2)));

constexpr int DM = 1024, NB = 4, SEQ = 8192, DEPTH = 4, CTXL = 256, DFF = 2816, INW = 2304, MODW = 9216;
constexpr int MLAT = NB * SEQ, MCTX = NB * CTXL, MTOT = MLAT + MCTX;
constexpr float L2E = 1.4426950408889634f;
constexpr size_t MiB = 1u << 20;
constexpr size_t WS_BAR = 1 * MiB - 65536;
constexpr size_t WS_MOD = 0, WS_ROPE = 1 * MiB, WS_XC = 2 * MiB, WS_WUP = 8 * MiB, WS_WDN = 96 * MiB, WS_WIN = 140 * MiB, WS_WOUT = 158 * MiB,
                 WS_H = 166 * MiB, WS_Q = 232 * MiB, WS_K = 298 * MiB, WS_KC = 338 * MiB, WS_VT = 340 * MiB, WS_VTC = 380 * MiB, WS_ACT = 382 * MiB, WS_P = 564 * MiB, WS_SS = 608 * MiB, WS_SW = 612 * MiB, WS_R = 615 * MiB, WS_END = 616 * MiB;
constexpr int LDS_BYTES = 147456;
constexpr int NWAVES = 8;

struct Params {
    const float *x, *c, *ctx, *c_ctx, *w_ada, *b_ada, *norm_g, *w_up, *w_down, *w_in, *w_out, *qk_g, *rpb, *sink;
    float* out; unsigned char* ws;
};

__device__ __forceinline__ unsigned f2bf(float f) { unsigned u = __builtin_bit_cast(unsigned, f); return (u + 0x7fffu + ((u >> 16) & 1u)) >> 16; }
typedef __bf16 bf16x2_t __attribute__((ext_vector_type(2)));
typedef float f32x2_t __attribute__((ext_vector_type(2)));
__device__ __forceinline__ unsigned pk2(float lo, float hi) { return __builtin_bit_cast(unsigned, __builtin_convertvector((f32x2_t){lo, hi}, bf16x2_t)); }
__device__ __forceinline__ float wave_sum(float v) {
#pragma unroll
    for (int o = 1; o < 64; o <<= 1) v += __shfl_xor(v, o);
    return v;
}

__device__ __forceinline__ int opaque_tid() { int t = threadIdx.x; asm volatile("" : "+v"(t)); return t; }
#define PHASE_IDS const int tid = opaque_tid(), lane = tid & 63, wave = __builtin_amdgcn_readfirstlane(tid >> 6); (void)tid; (void)lane; (void)wave
__device__ __forceinline__ void p0_mod(const Params& p, LAS unsigned char* lds, float* MOD) {
    PHASE_IDS;
    LAS float* sc = (LAS float*)lds;
    LAS float* red = sc + 5 * 1024;
    for (int i = tid; i < 5 * 1024; i += 512) { const int b = i >> 10, k = i & 1023; const float v = b < 4 ? p.c[b * 1024 + k] : p.c_ctx[k]; sc[i] = v / (1.0f + __expf(-v)); }
    __syncthreads();
    for (int item = blockIdx.x; item < DEPTH * 72; item += gridDim.x) {
        const int l = item / 72, n0 = (item % 72) * 128;
        const float* W = p.w_ada + (size_t)l * DM * MODW + n0 + 2 * lane;
        float a[5][2];
#pragma unroll
        for (int b = 0; b < 5; ++b) { a[b][0] = 0.f; a[b][1] = 0.f; }
#pragma unroll 8
        for (int kk = 0; kk < 128; ++kk) { const int k = wave * 128 + kk; const float2 w = *(const float2*)(W + (size_t)k * MODW);
#pragma unroll
            for (int b = 0; b < 5; ++b) { const float s = sc[b * 1024 + k]; a[b][0] += s * w.x; a[b][1] += s * w.y; } }
#pragma unroll
        for (int b = 0; b < 5; ++b) { red[(wave * 5 + b) * 128 + 2 * lane] = a[b][0]; red[(wave * 5 + b) * 128 + 2 * lane + 1] = a[b][1]; }
        __syncthreads();
        for (int o = tid; o < 640; o += 512) { const int b = o >> 7, n = o & 127; float s = 0.f;
#pragma unroll
            for (int w = 0; w < 8; ++w) s += red[(w * 5 + b) * 128 + n];
            MOD[(size_t)(l * 5 + b) * MODW + n0 + n] = s + p.b_ada[l * MODW + n0 + n]; }
        __syncthreads();
    }
}

__device__ __forceinline__ float r6(float x) { unsigned u = __float_as_uint(x); u = (u + 0xffffu + ((u >> 17) & 1u)) & 0xfffe0000u; return __uint_as_float(u); }
__device__ __forceinline__ void p0_transpose_item(const float* W, int K, int N, bf16* WT, int k0, int n0, int r0, LAS float* scr, int lane) {
#pragma unroll 8
    for (int i = 0; i < 32; ++i) { const int kk = 2 * i + (lane >> 5); scr[kk * 33 + (lane & 31)] = W[(size_t)(k0 + kk) * N + n0 + (lane & 31)]; }
    asm volatile("s_waitcnt lgkmcnt(0)" ::: "memory");
    const int c = lane & 7;
#pragma unroll
    for (int j = 0; j < 4; ++j) { const int n = (lane >> 3) + 8 * j; const LAS float* s = scr + (8 * c) * 33 + n;
        v4u o; o.x = pk2(r6(s[0 * 33]), r6(s[1 * 33])); o.y = pk2(r6(s[2 * 33]), r6(s[3 * 33])); o.z = pk2(r6(s[4 * 33]), r6(s[5 * 33])); o.w = pk2(r6(s[6 * 33]), r6(s[7 * 33]));
        *(v4u*)(WT + (size_t)(r0 + n) * K + k0 + 8 * c) = o; }
    asm volatile("s_waitcnt lgkmcnt(0)" ::: "memory");
}
__device__ __forceinline__ void p0_weights(const Params& p, LAS unsigned char* lds, unsigned char* ws) {
    PHASE_IDS;
    LAS float* scr = (LAS float*)(lds + 65536 + wave * 8704);
    const int gw = blockIdx.x * NWAVES + wave, NGW = gridDim.x * NWAVES;
    constexpr int I_UP = 16 * 176, I_DN = 44 * 32, I_IN = 16 * 72, I_OUT = 16 * 32;
    constexpr int T_UP = 8 * I_UP, T_DN = 8 * I_DN, T_IN = 4 * I_IN, T_OUT = 4 * I_OUT;
    for (int it = gw; it < T_UP + T_DN + T_IN + T_OUT; it += NGW) {
        int r = it;
        if (r < T_UP) { const int mtx = r / I_UP, q = r % I_UP, kb = q / 176, nb = q % 176, n0 = nb * 32;
            const int j = n0 < DFF ? n0 : n0 - DFF; const int r0 = (j >> 7) * 256 + (n0 < DFF ? 0 : 128) + (j & 127);
            p0_transpose_item(p.w_up + (size_t)mtx * DM * 2 * DFF, DM, 2 * DFF, (bf16*)(ws + WS_WUP) + (size_t)mtx * 2 * DFF * DM, kb * 64, n0, r0, scr, lane); continue; }
        r -= T_UP;
        if (r < T_DN) { const int mtx = r / I_DN, q = r % I_DN, kb = q / 32, nb = q % 32;
            p0_transpose_item(p.w_down + (size_t)mtx * DFF * DM, DFF, DM, (bf16*)(ws + WS_WDN) + (size_t)mtx * DM * DFF, kb * 64, nb * 32, nb * 32, scr, lane); continue; }
        r -= T_DN;
        if (r < T_IN) { const int mtx = r / I_IN, q = r % I_IN, kb = q / 72, nb = q % 72, n0 = nb * 32;
            const int head = n0 >> 6, bj = (n0 >> 5) & 1; const int r0 = (head >> 2) * 256 + bj * 128 + (head & 3) * 32;
            p0_transpose_item(p.w_in + (size_t)mtx * DM * INW, DM, INW, (bf16*)(ws + WS_WIN) + (size_t)mtx * INW * DM, kb * 64, n0, r0, scr, lane); continue; }
        r -= T_IN;
        { const int mtx = r / I_OUT, q = r % I_OUT, kb = q / 32, nb = q % 32;
            p0_transpose_item(p.w_out + (size_t)mtx * DM * DM, DM, DM, (bf16*)(ws + WS_WOUT) + (size_t)mtx * DM * DM, kb * 64, nb * 32, nb * 32, scr, lane); }
    }
}

__device__ __forceinline__ void norm_phase(const float* xlat, const float* xctx, float* XC, const float* P, int npart, bf16* H, float* SS, const float* g, const float* modl, int jshift, int row_begin, int Mrows) {
    PHASE_IDS;
    const int gw = blockIdx.x * NWAVES + wave, NGW = gridDim.x * NWAVES;
    for (int row = row_begin + gw; row < Mrows; row += NGW) {
        const int cond = row < MLAT ? (row >> 13) : 4;
        const float* xr = row < MLAT ? xlat + (size_t)row * DM : xctx + (size_t)(row - MLAT) * DM;
        f32x4 v[4]; float s = 0.f;
#pragma unroll
        for (int j = 0; j < 4; ++j) v[j] = *((const f32x4*)xr + lane + 64 * j);
        if (row >= MLAT) {
            const float* pr = P + (size_t)(row - MLAT) * DM;
            for (int sp = 0; sp < npart; ++sp) {
#pragma unroll
                for (int j = 0; j < 4; ++j) v[j] += *((const f32x4*)(pr + (size_t)sp * MCTX * DM) + lane + 64 * j); }
#pragma unroll
            for (int j = 0; j < 4; ++j) *((f32x4*)(XC + (size_t)(row - MLAT) * DM) + lane + 64 * j) = v[j];
        }
#pragma unroll
        for (int j = 0; j < 4; ++j) { const f32x4 q = v[j] * v[j]; s += (q[0] + q[1]) + (q[2] + q[3]); }
        const float tot = wave_sum(s);
        if (lane == 0) SS[row] = rsqrtf(tot * (1.0f / DM) + 1e-6f);
        const float* sh = modl + (size_t)cond * MODW + jshift * DM; const float* scl = sh + DM;
        unsigned long long* o8 = (unsigned long long*)(H + (size_t)row * DM) + lane;
#pragma unroll
        for (int j = 0; j < 4; ++j) { const f32x4 gg = *((const f32x4*)g + lane + 64 * j), s4 = *((const f32x4*)scl + lane + 64 * j);
            const f32x4 o = v[j] * gg * (1.0f + s4);
            o8[64 * j] = (unsigned long long)pg8::rnd6pk(pk2(o[0], o[1])) | ((unsigned long long)pg8::rnd6pk(pk2(o[2], o[3])) << 32); }
    }
}

__device__ __forceinline__ void sw_phase(const unsigned char* ws, const float* MOD, float* SW) {
    PHASE_IDS;
    const int gw = blockIdx.x * NWAVES + wave, NGW = gridDim.x * NWAVES;
    for (int mtx = 0; mtx < 12; ++mtx) {
        const int l = mtx / 3, sub = mtx % 3, N = sub == 1 ? INW : 2 * DFF;
        const bf16* Bt = sub == 1 ? (const bf16*)(ws + WS_WIN) + (size_t)l * INW * DM : (const bf16*)(ws + WS_WUP) + (size_t)(l * 2 + (sub >> 1)) * 2 * DFF * DM;
        const float* sh = MOD + (size_t)l * 5 * MODW + 3 * sub * DM + lane * 16;
        f32x4 shv[5][4];
#pragma unroll
        for (int c = 0; c < 5; ++c)
#pragma unroll
            for (int j = 0; j < 4; ++j) shv[c][j] = *(const f32x4*)(sh + (size_t)c * MODW + 4 * j);
        for (int n = gw; n < N; n += NGW) {
            const v4u w0 = *(const v4u*)(Bt + (size_t)n * DM + lane * 16), w1 = *(const v4u*)(Bt + (size_t)n * DM + lane * 16 + 8);
            f32x4 wf[4];
            wf[0] = (f32x4){__uint_as_float(w0.x << 16), __uint_as_float(w0.x & 0xffff0000u), __uint_as_float(w0.y << 16), __uint_as_float(w0.y & 0xffff0000u)};
            wf[1] = (f32x4){__uint_as_float(w0.z << 16), __uint_as_float(w0.z & 0xffff0000u), __uint_as_float(w0.w << 16), __uint_as_float(w0.w & 0xffff0000u)};
            wf[2] = (f32x4){__uint_as_float(w1.x << 16), __uint_as_float(w1.x & 0xffff0000u), __uint_as_float(w1.y << 16), __uint_as_float(w1.y & 0xffff0000u)};
            wf[3] = (f32x4){__uint_as_float(w1.z << 16), __uint_as_float(w1.z & 0xffff0000u), __uint_as_float(w1.w << 16), __uint_as_float(w1.w & 0xffff0000u)};
            float d[5];
#pragma unroll
            for (int c = 0; c < 5; ++c) { f32x4 a = shv[c][0] * wf[0] + shv[c][1] * wf[1] + shv[c][2] * wf[2] + shv[c][3] * wf[3]; d[c] = wave_sum((a[0] + a[1]) + (a[2] + a[3])); }
            if (lane < 5) { const float v = lane == 0 ? d[0] : lane == 1 ? d[1] : lane == 2 ? d[2] : lane == 3 ? d[3] : d[4]; SW[((size_t)mtx * 5 + lane) * (2 * DFF) + n] = v; }
        }
    }
}

__device__ __forceinline__ void rfactor_phase(const float* SS, float* R) {
    PHASE_IDS;
    for (int row = blockIdx.x * 512 + tid; row < MLAT; row += gridDim.x * 512) {
        const f32x4* p = (const f32x4*)(SS + (size_t)row * 16); const f32x4 a = p[0], b = p[1], c = p[2], d = p[3];
        const float t = ((a[0] + a[1]) + (a[2] + a[3])) + ((b[0] + b[1]) + (b[2] + b[3])) + ((c[0] + c[1]) + (c[2] + c[3])) + ((d[0] + d[1]) + (d[2] + d[3]));
        R[row] = rsqrtf(t * (1.0f / DM) + 1e-6f);
    }
}

struct AttnBufs { const bf16* Q; const bf16* K; const bf16* KC; const bf16* VT; const bf16* VTC; bf16* O; const float* sink; };

template <int MASK, int QH>
__device__ __forceinline__ void attn_tile(bf16x8 (&kf)[2][4], const bf16x8 (&qf)[4], f32x16 (&ot)[2], float& l,
                                          const bf16* vt, const bf16* knext, int lane, int mp0, int mp1, const LAS float* tab, float negB, const unsigned (&mw)[2][8]) {
#define ATT_LIVE(kb, i) (MASK != 1 || (QH == 0 ? (32 * (kb) + 8 * ((i) >> 2) < 40) : (32 * (kb) + 8 * ((i) >> 2) >= 24)))
#define ATT_KS_LIVE(ks) (ATT_LIVE((ks) >> 1, 8 * ((ks) & 1)) || ATT_LIVE((ks) >> 1, 8 * ((ks) & 1) + 4))
    bf16x8 vfr[2][4];
#pragma unroll
    for (int db = 0; db < 2; ++db)
#pragma unroll
        for (int ks = 0; ks < 4; ++ks) if (ATT_KS_LIVE(ks)) vfr[db][ks] = *(const bf16x8*)(vt + ((db * 4 + ks) * 64 + lane) * 8);
    f32x16 st[2];
#pragma unroll
    for (int kb = 0; kb < 2; ++kb) {
#pragma unroll
        for (int i = 0; i < 16; ++i) st[kb][i] = negB;
#pragma unroll
        for (int kk = 0; kk < 4; ++kk) st[kb] = __builtin_amdgcn_mfma_f32_32x32x16_bf16(kf[kb][kk], qf[kk], st[kb], 0, 0, 0);
    }
#pragma unroll
    for (int kb = 0; kb < 2; ++kb)
#pragma unroll
        for (int kk = 0; kk < 4; ++kk) kf[kb][kk] = *(const bf16x8*)(knext + ((kb * 4 + kk) * 64 + lane) * 8);
    float ls = 0.f;
    bf16x8 pf[4];
#pragma unroll
    for (int kb = 0; kb < 2; ++kb)
#pragma unroll
        for (int hs = 0; hs < 2; ++hs) {
            if (!ATT_KS_LIVE(2 * kb + hs)) continue;
            float pv[8];
#pragma unroll
            for (int j = 0; j < 8; ++j) {
                const int i = 8 * hs + j, kc = 32 * kb + 8 * (i >> 2) + (i & 3);
                if (!ATT_LIVE(kb, i)) { pv[j] = 0.f; continue; }
                float s = st[kb][i];
                if (MASK == 1) s += tab[mp1 + kc];
                float pe = __builtin_amdgcn_exp2f(s);
                if (MASK == 2) pe = ((unsigned)(kc + mp0) <= 256u) ? pe : 0.f;
                pv[j] = pe; if (MASK != 1) ls += pe;
            }
            v4u w; w.x = pk2(pv[0], pv[1]); w.y = pk2(pv[2], pv[3]); w.z = pk2(pv[4], pv[5]); w.w = pk2(pv[6], pv[7]);
            if (MASK == 1) {
                unsigned wm[4] = {w.x, w.y, w.z, w.w};
#pragma unroll
                for (int t = 0; t < 4; ++t) { if (!ATT_LIVE(kb, 8 * hs + 2 * t)) { wm[t] = 0u; continue; }
                    wm[t] &= mw[kb][4 * hs + t];
                    ls += __uint_as_float(wm[t] << 16); ls += __uint_as_float(wm[t] & 0xffff0000u); }
                w.x = wm[0]; w.y = wm[1]; w.z = wm[2]; w.w = wm[3];
            }
            pf[2 * kb + hs] = __builtin_bit_cast(bf16x8, w);
        }
    l += ls;
#pragma unroll
    for (int db = 0; db < 2; ++db)
#pragma unroll
        for (int ks = 0; ks < 4; ++ks) if (ATT_KS_LIVE(ks)) ot[db] = __builtin_amdgcn_mfma_f32_32x32x16_bf16(vfr[db][ks], pf[ks], ot[db], 0, 0, 0);
#undef ATT_LIVE
#undef ATT_KS_LIVE
}

template <int KIND, int QH>
__device__ __forceinline__ void attn_unit(const AttnBufs& a, int u, int lane, const LAS float* rpbt, float bndA, float bndB) {
    const int half = lane >> 5, r32 = lane & 31;
    int b, head16, hv, qrow0; float l = 0.f, bound;
    int r = 0, r0 = 0, q0 = 0, h = 0; float sinkv = 0.f; bool has_sink = false;
    if (KIND == 0) { r = u & 127; h = (u >> 7) & 7; b = u >> 10; qrow0 = b * SEQ + r * 64 + 32 * QH; head16 = h; hv = h; bound = bndA;
        r0 = r - 4; r0 = r0 < 0 ? 0 : (r0 > 120 ? 120 : r0); }
    else if (KIND == 1) { const int qb = u & 255, hq = (u >> 8) & 7; b = u >> 11; q0 = 32 * qb; qrow0 = b * SEQ + q0; head16 = 8 + hq; const int kvh = hq >> 2; hv = 8 + kvh;
        sinkv = a.sink[hq]; has_sink = true; bound = fmaxf(bndB, sinkv); }
    else { const int qblk = u & 7; head16 = (u >> 3) & 15; b = u >> 7; qrow0 = MLAT + b * CTXL + 32 * qblk;
        if (head16 < 8) { hv = head16; bound = bndA; } else { const int kvh = (head16 - 8) >> 2; hv = 8 + kvh; sinkv = a.sink[head16 - 8]; has_sink = true; bound = fmaxf(bndB, sinkv); } }
    const float negB = -bound * L2E;
    if (has_sink) l = 0.5f * __builtin_amdgcn_exp2f(sinkv * L2E + negB);
    bf16x8 qf[4], kf[2][4];
    const bf16* qp = a.Q + (size_t)(qrow0 + r32) * DM + head16 * 64 + 8 * half;
#pragma unroll
    for (int kk = 0; kk < 4; ++kk) qf[kk] = *(const bf16x8*)(qp + 16 * kk);
    f32x16 ot[2]; unsigned mw[2][8];
#pragma unroll
    for (int db = 0; db < 2; ++db) {
#pragma unroll
        for (int i = 0; i < 16; ++i) ot[db][i] = 0.f;
#pragma unroll
        for (int i = 0; i < 8; ++i) mw[db][i] = 0u; }
    const bf16* kc0 = a.KC + (size_t)(b * 10 + hv) * 4 * 4096;
    const bf16* vc0 = a.VTC + (size_t)(b * 10 + hv) * 4 * 4096;
#pragma unroll
    for (int kb = 0; kb < 2; ++kb)
#pragma unroll
        for (int kk = 0; kk < 4; ++kk) kf[kb][kk] = *(const bf16x8*)(kc0 + ((kb * 4 + kk) * 64 + lane) * 8);
    const bf16* kl0 = a.K + (size_t)(b * 10 + hv) * 128 * 4096;
    const bf16* vl0 = a.VT + (size_t)(b * 10 + hv) * 128 * 4096;
    int ntl = 0, t0 = 0;
    if (KIND == 0) { ntl = 8; t0 = r0 * 64; }
    int ti0 = 0, nint = 0, tbA = 0, tbB = 0; bool hasA = false, hasB = false;
    if (KIND == 1) { const int lo = (q0 - 34) & ~63; int a0 = lo, a1 = lo + 192; if (a0 < 0) a0 = 0; if (a1 > SEQ) a1 = SEQ; ti0 = a0; nint = (a1 - a0) >> 6;
        tbA = lo - 64; hasA = tbA >= 0; tbB = lo + 192; hasB = tbB < SEQ; ntl = (hasA ? 1 : 0) + (hasB ? 1 : 0); t0 = hasA ? tbA : tbB; }
    const int n1 = 4 + nint;
#pragma unroll 1
    for (int j = 0; j < n1; ++j) {
        const int jn = j + 1;
        const bf16* kn = jn < 4 ? kc0 + jn * 4096 : (jn < n1 ? kl0 + (size_t)(ti0 + 64 * (jn - 4)) * 64 : (ntl > 0 ? kl0 + (size_t)t0 * 64 : kc0));
        const bf16* vt = j < 4 ? vc0 + j * 4096 : vl0 + (size_t)(ti0 + 64 * (j - 4)) * 64;
        attn_tile<0, 0>(kf, qf, ot, l, vt, kn, lane, 0, 0, rpbt, negB, mw);
    }
    if (KIND == 0) {
        const int c = QH * 32 + r32; int c0 = c - 8; c0 = c0 < 0 ? 0 : (c0 > 48 ? 48 : c0);
#pragma unroll
        for (int kb = 0; kb < 2; ++kb)
#pragma unroll
            for (int pp = 0; pp < 8; ++pp) { const int i = 2 * pp, kc = 32 * kb + 8 * (i >> 2) + (i & 3) + 4 * half - c0;
                mw[kb][pp] = ((unsigned)kc < 16u ? 0x0000ffffu : 0u) | ((unsigned)(kc + 1) < 16u ? 0xffff0000u : 0u); }
#pragma unroll 1
        for (int i = 0; i < 8; ++i) {
            const int tk = t0 + 64 * i; const bf16* kn = kl0 + (size_t)(i < 7 ? tk + 64 : tk) * 64;
            const int dr = r0 + i - r + 7;
            attn_tile<1, QH>(kf, qf, ot, l, vl0 + (size_t)tk * 64, kn, lane, 4 * half - c0, h * 640 + 64 + dr * 31 + 15 - c + 4 * half, rpbt, negB, mw);
        }
    }
    if (KIND == 1) {
        const int q = q0 + r32;
#pragma unroll 1
        for (int i = 0; i < ntl; ++i) {
            const int tk = (i == 0 && hasA) ? tbA : tbB; const bf16* kn = kl0 + (size_t)((i == 0 && hasA && hasB) ? tbB : tk) * 64;
            attn_tile<2, 0>(kf, qf, ot, l, vl0 + (size_t)tk * 64, kn, lane, tk + 4 * half - q + 128, 0, rpbt, negB, mw);
        }
    }
    l += __shfl_xor(l, 32);
    const float inv = 1.0f / l;
    bf16* op = a.O + (size_t)(qrow0 + r32) * DM + head16 * 64 + 4 * half;
#pragma unroll
    for (int db = 0; db < 2; ++db)
#pragma unroll
        for (int g = 0; g < 4; ++g) { v2u w; w.x = pg8::rnd6pk(pk2(ot[db][4 * g] * inv, ot[db][4 * g + 1] * inv)); w.y = pg8::rnd6pk(pk2(ot[db][4 * g + 2] * inv, ot[db][4 * g + 3] * inv));
            *(v2u*)(op + 32 * db + 8 * g) = w; }
}

__device__ __forceinline__ float wave_max(float v) {
#pragma unroll
    for (int o = 1; o < 64; o <<= 1) v = fmaxf(v, __shfl_xor(v, o));
    return v;
}
__device__ __forceinline__ void attn_phase(const AttnBufs& a, const float* rpb_l, const float* qkg, bool with_ctx, LAS unsigned char* lds) {
    PHASE_IDS;
    LAS float* tab = (LAS float*)lds;
    LAS float* red = tab + 8 * 640;
    float bm = 0.f;
    for (int i = tid; i < 8 * 640; i += 512) { const int h = i / 640, o = i % 640 - 64; const float v = (o >= 0 && o < 465) ? rpb_l[h * 465 + o] : 0.f; tab[i] = v * L2E; bm = fmaxf(bm, fabsf(v)); }
    bm = wave_max(bm); if (lane == 0) red[wave] = bm;
    __syncthreads();
    bm = 0.f;
#pragma unroll
    for (int w = 0; w < 8; ++w) bm = fmaxf(bm, red[w]);
    const float gqa = wave_max(fabsf(qkg[lane])), gka = wave_max(fabsf(qkg[64 + lane])), gqb = wave_max(fabsf(qkg[128 + lane])), gkb = wave_max(fabsf(qkg[192 + lane]));
    const float bndA = 8.16f * gqa * gka + bm, bndB = 8.16f * gqb * gkb;
    const int gw = blockIdx.x * NWAVES + wave, NGW = gridDim.x * NWAVES;
    for (int u = gw; u < 4096; u += NGW) attn_unit<0, 0>(a, u, lane, tab, bndA, bndB);
    for (int u = gw; u < 4096; u += NGW) attn_unit<0, 1>(a, u, lane, tab, bndA, bndB);
    for (int u = gw; u < 8192; u += NGW) attn_unit<1, 0>(a, u, lane, tab, bndA, bndB);
    if (with_ctx) for (int u = gw; u < 512; u += NGW) attn_unit<2, 0>(a, u, lane, tab, bndA, bndB);
}

#define XB_TMO      128
#define XB_XCNT(j)  (256  + 64 * (j))
#define XB_XSUB(j)  (1280 + 64 * (j))
#define XB_XGEN(j)  (2304 + 64 * (j))
#define XB_TOP      3328
#define XB_TOPGEN   3392
#define XCD_BAR_WORDS 3456
#define XB_SPIN_CAP (1u << 18)

__device__ __forceinline__ unsigned xb_ld(unsigned* p)              { return __hip_atomic_load(p, __ATOMIC_RELAXED, __HIP_MEMORY_SCOPE_AGENT); }
__device__ __forceinline__ unsigned xb_add(unsigned* p, unsigned v) { return __hip_atomic_fetch_add(p, v, __ATOMIC_RELAXED, __HIP_MEMORY_SCOPE_AGENT); }
__device__ __forceinline__ unsigned xb_xcc_id() { return (unsigned)__builtin_amdgcn_s_getreg((3 << 11) | 20) & 0xFu; }
#define XB_SPIN(cond, bar) do { unsigned _sp = 0; while (cond) { __builtin_amdgcn_s_sleep(1); \
    if ((++_sp & 255u) == 0u) { if (xb_ld(&(bar)[XB_TMO])) break; if (_sp > XB_SPIN_CAP) { atomicAdd(&(bar)[XB_TMO], 1u); break; } } } } while (0)

struct XcdBarrier {
    unsigned* bar; unsigned x;
    volatile LAS unsigned* st;
};

__device__ __forceinline__ XcdBarrier xcd_barrier_post(unsigned* bar, volatile LAS unsigned* st) {
    XcdBarrier b; b.bar = bar; b.x = xb_xcc_id(); b.st = st;
    if (threadIdx.x == 0) (void)xb_add(&bar[XB_XCNT(b.x)], 1u);
    return b;
}
__device__ __forceinline__ void xcd_barrier_complete(unsigned* bar, unsigned x, unsigned& nloc, unsigned& nx) {
    const unsigned G = gridDim.x * gridDim.y * gridDim.z;
    unsigned sum, cnt, mine, sp = 0u;
    for (;;) {
        sum = 0u; cnt = 0u; mine = 0u;
#pragma unroll
        for (unsigned j = 0; j < 16; ++j) { const unsigned c = xb_ld(&bar[XB_XCNT(j)]); sum += c; cnt += (c > 0u) ? 1u : 0u; mine = (j == x) ? c : mine; }
        if (sum == G) break;
        __builtin_amdgcn_s_sleep(1);
        if ((++sp & 255u) == 0u) { if (xb_ld(&bar[XB_TMO])) break; if (sp > XB_SPIN_CAP) { atomicAdd(&bar[XB_TMO], 1u); break; } }
    }
    nloc = mine > 0u ? mine : 1u; nx = cnt > 0u ? cnt : 1u;
}

__device__ __forceinline__ void xcd_barrier(const XcdBarrier& b) {
    asm volatile("s_waitcnt vmcnt(0)" ::: "memory");
    __syncthreads();
    if (threadIdx.x == 0) {
        unsigned* bar = b.bar;
        __builtin_amdgcn_s_waitcnt(0);
        unsigned nloc = b.st[0], nx = b.st[1];
        if (nloc == 0u) { xcd_barrier_complete(bar, b.x, nloc, nx); b.st[0] = nloc; b.st[1] = nx; }
        const unsigned old = xb_add(&bar[XB_XSUB(b.x)], 1u);
        const unsigned gen = old / nloc;
        if (old + 1u == (gen + 1u) * nloc) {
            __builtin_amdgcn_fence(__ATOMIC_RELEASE, "agent");
            asm volatile("s_waitcnt vmcnt(0)" ::: "memory");
            const unsigned og = xb_add(&bar[XB_TOP], 1u);
            const unsigned tg = og / nx;
            if (og + 1u == (tg + 1u) * nx) xb_add(&bar[XB_TOPGEN], 1u);
            else XB_SPIN(xb_ld(&bar[XB_TOPGEN]) == tg, bar);
            __builtin_amdgcn_fence(__ATOMIC_ACQUIRE, "agent");
            xb_add(&bar[XB_XGEN(b.x)], 1u);
            asm volatile("s_waitcnt vmcnt(0)" ::: "memory");
        } else {
            XB_SPIN(xb_ld(&bar[XB_XGEN(b.x)]) == gen, bar);
            __builtin_amdgcn_fence(__ATOMIC_ACQUIRE, "agent");
            asm volatile("s_waitcnt vmcnt(0)" ::: "memory");
        }
    }
    __syncthreads();
}

__global__ void __launch_bounds__(NWAVES * 64, 2) fwd_mega(Params p) {
    extern __shared__ __attribute__((aligned(16))) unsigned char lds_raw[];
    LAS unsigned char* lds = (LAS unsigned char*)lds_raw;
    cg::grid_group grid = cg::this_grid();
    unsigned char* ws = p.ws;
    float* SS = (float*)(ws + WS_SS); float* SW = (float*)(ws + WS_SW); float* RF = (float*)(ws + WS_R);
    float* MOD = (float*)(ws + WS_MOD); float* ROPE = (float*)(ws + WS_ROPE); float* XC = (float*)(ws + WS_XC);
    bf16* H = (bf16*)(ws + WS_H); bf16* Qb = (bf16*)(ws + WS_Q); bf16* Kb = (bf16*)(ws + WS_K); bf16* KC = (bf16*)(ws + WS_KC); bf16* VT = (bf16*)(ws + WS_VT); bf16* VTC = (bf16*)(ws + WS_VTC);
    bf16* ACT = (bf16*)(ws + WS_ACT);
    const int G = gridDim.x;

    volatile LAS unsigned* bst = (volatile LAS unsigned*)(lds + LDS_BYTES - 64);
    { PHASE_IDS; if (tid < 2) bst[tid] = 0u;
      if (blockIdx.x == 0) for (int i = tid; i < XCD_BAR_WORDS; i += 512) ((unsigned*)(ws + WS_BAR))[i] = 0u; }
    if (blockIdx.x == 0) {
        PHASE_IDS;
        for (int i = tid; i < 3072; i += 512) { const int pos = i >> 4, f = i & 15; const float pv = (float)(pos < 128 ? pos : pos - 128);
            const float invf = powf(10000.0f, -(float)(2 * f) / 32.0f); const float ang = pv * invf; ROPE[i] = cosf(ang); ROPE[3072 + i] = sinf(ang); }
    }
#ifndef NO_P0
    p0_mod(p, lds, MOD);
    p0_weights(p, lds, ws);
#endif
    grid.sync();
    const XcdBarrier xbar = xcd_barrier_post((unsigned*)(ws + WS_BAR), bst);
#define GSYNC() xcd_barrier(xbar)
    sw_phase(ws, MOD, SW);
    norm_phase(p.x, p.ctx, XC, (const float*)(ws + WS_P), 0, H, RF, p.norm_g, MOD, 0, 0, MTOT);
    GSYNC();

    for (int l = 0; l < DEPTH; ++l) {
        const bool last = (l == DEPTH - 1);
        const float* modl = MOD + (size_t)l * 5 * MODW;
        for (int sub = 0; sub < 3; ++sub) {
            const bool first = (l == 0 && sub == 0);
            const float* xlat = first ? p.x : p.out; const float* xctx = first ? p.ctx : XC;
            const int Mrows = (last && sub == 2) ? MLAT : MTOT;
            bf16* Hs = sub == 2 ? Qb : H;
            if (!first) {
                rfactor_phase(SS, RF);
                if (Mrows > MLAT) norm_phase(xlat, xctx, XC, (const float*)(ws + WS_P), sub == 2 ? 4 : 11, Hs, RF, p.norm_g + (size_t)(l * 3 + sub) * DM, modl, 3 * sub, MLAT, Mrows);
                GSYNC();
            }
            if (sub != 1) {
                const int s = sub >> 1;
                pg8::Gemm g{Hs, (const bf16*)(ws + WS_WUP) + (size_t)(l * 2 + s) * 2 * DFF * DM, Mrows, 2 * DFF, DM};
                pg8::StaticOrder S; S.init(Mrows, 2 * DFF, G, (int)blockIdx.x, DM / 64);
                pg8::EpiUp E{ACT, RF, SW + (size_t)(l * 3 + sub) * 5 * 2 * DFF, lds + 131072};
#ifndef NO_UP
                pg8::gemm_phase<pg8::EpiUp, pg8::StaticOrder, true, true>(lds, g, S, E);
#endif
                GSYNC();
            } else {
                pg8::Gemm g{H, (const bf16*)(ws + WS_WIN) + (size_t)l * INW * DM, MTOT, INW, DM};
                pg8::StaticOrder S; S.init(MTOT, INW, G, (int)blockIdx.x, DM / 64);
                pg8::EpiQKV E{Qb, Kb, KC, VT, VTC, p.qk_g + (size_t)l * 4 * 64, ROPE, RF, SW + (size_t)(l * 3 + 1) * 5 * 2 * DFF, lds + 131072};
#ifndef NO_QKV
                pg8::gemm_phase<pg8::EpiQKV, pg8::StaticOrder, true, true>(lds, g, S, E);
#endif
                GSYNC();
                AttnBufs ab{Qb, Kb, KC, VT, VTC, H, p.sink + l * 8};
#ifndef NO_ATTN
                attn_phase(ab, p.rpb + (size_t)l * 8 * 465, p.qk_g + (size_t)l * 4 * 64, !last, lds);
#endif
                GSYNC();
            }
            {
                const int Mr = (last && sub >= 1) ? MLAT : MTOT;
                const bf16* A = sub == 1 ? H : ACT; const int K = sub == 1 ? DM : DFF;
                const bf16* Bt = sub == 1 ? (const bf16*)(ws + WS_WOUT) + (size_t)l * DM * DM : (const bf16*)(ws + WS_WDN) + (size_t)(l * 2 + (sub >> 1)) * DM * DFF;
                pg8::Gemm g{A, Bt, Mr, DM, K};
                pg8::ResOrder S; S.init(G, (int)blockIdx.x, K / 64, Mr == MTOT ? K / 256 : 0);
                const int nl = sub == 2 ? l + 1 : l, ns = sub == 2 ? 0 : sub + 1; const bool has_next = nl < DEPTH;
                const int nlc = has_next ? nl : l;
                pg8::EpiRes E;
                E.src_lat = xlat; E.dst_lat = p.out; E.dst_ctx = (float*)(ws + WS_P); E.modv = modl + (3 * sub + 2) * DM;
                E.XGa = H; E.XGb = Qb; E.SS = SS; E.gnext = p.norm_g + (size_t)(nlc * 3 + ns) * DM; E.sclnext = MOD + (size_t)nlc * 5 * MODW + (3 * ns + 1) * DM;
                E.flags = (has_next ? 1 : 0) | (ns == 2 ? 2 : 0) | (sub == 1 ? 4 : 0);
#ifndef NO_RES
                pg8::gemm_phase<pg8::EpiRes, pg8::ResOrder, true, true>(lds, g, S, E);
#endif
                GSYNC();
            }
        }
    }
}

extern "C" void kernel_launch(void* const* d_in, const int* in_sizes, int n_in, void* d_out, int out_size, void* d_ws, size_t ws_size, hipStream_t stream) {
    static int grid = 0;
    if (grid == 0) {
        if (n_in != 14 || out_size != MLAT * DM || ws_size < WS_END) { fprintf(stderr, "kernel_launch: unexpected shapes (n_in %d out %d ws %zu)\n", n_in, out_size, ws_size); grid = -1; return; }
        int dev = 0, cus = 0, per_cu = 0;
        hipGetDevice(&dev); hipDeviceGetAttribute(&cus, hipDeviceAttributeMultiprocessorCount, dev);
        if (hipFuncSetAttribute((const void*)fwd_mega, hipFuncAttributeMaxDynamicSharedMemorySize, LDS_BYTES) != hipSuccess) { fprintf(stderr, "kernel_launch: hipFuncSetAttribute failed\n"); grid = -1; return; }
        if (hipOccupancyMaxActiveBlocksPerMultiprocessor(&per_cu, (const void*)fwd_mega, NWAVES * 64, LDS_BYTES) != hipSuccess || per_cu < 1) { fprintf(stderr, "kernel_launch: occupancy query says %d\n", per_cu); per_cu = 1; }
        (void)hipGetLastError();
        grid = cus * per_cu;
    }
    if (grid < 0) return;
    Params p{};
    p.x = (const float*)d_in[0]; p.c = (const float*)d_in[1]; p.ctx = (const float*)d_in[2]; p.c_ctx = (const float*)d_in[3]; p.w_ada = (const float*)d_in[4]; p.b_ada = (const float*)d_in[5];
    p.norm_g = (const float*)d_in[6]; p.w_up = (const float*)d_in[7]; p.w_down = (const float*)d_in[8]; p.w_in = (const float*)d_in[9]; p.w_out = (const float*)d_in[10];
    p.qk_g = (const float*)d_in[11]; p.rpb = (const float*)d_in[12]; p.sink = (const float*)d_in[13];
    p.out = (float*)d_out; p.ws = (unsigned char*)d_ws;
    void* args[] = {&p};
    hipError_t e = hipLaunchCooperativeKernel((const void*)fwd_mega, dim3(grid), dim3(NWAVES * 64), args, LDS_BYTES, stream);
    if (e != hipSuccess) fprintf(stderr, "kernel_launch: cooperative launch failed: %s (grid %d)\n", hipGetErrorString(e), grid);
}
```

```cpp
#include <hip/hip_runtime.h>
#include <hip/hip_cooperative_groups.h>
#include <cstdio>
#include <cstdint>
namespace cg = cooperative_groups;
namespace pg8 {
#define PG8_LAS __attribute__((address_space(3)))
typedef unsigned short bf16_t;
typedef short bf16x8 __attribute__((ext_vector_type(8)));
typedef float f32x4 __attribute__((ext_vector_type(4)));
typedef unsigned u32x4 __attribute__((ext_vector_type(4)));
constexpr int BM = 256, BK = 64, HALF = 128, HTB = HALF * BK * 2  , STAGE_BYTES = 8 * HTB, NXCD = 8, WGM = 8;

__host__ __device__ __forceinline__ int lds_byte(int r, int c) { const int st = (r >> 4) * 2 + (c >> 5), rr = r & 15, cc = c & 31, ob = rr * 64 + cc * 2; return st * 1024 + (ob ^ (((ob >> 9) & 1) << 5)); }
__host__ __device__ __forceinline__ void stage_rc(int b, int& R, int& C) { const int st = b / 1024, sb = b % 1024, swz = sb ^ (((sb >> 9) & 1) << 5); R = (st >> 1) * 16 + swz / 64; C = (st & 1) * 32 + (swz % 64) / 2; }
__host__ __device__ __forceinline__ int perm32(int rho) { const int n = rho >> 4, i = rho & 15; return 8 * (i >> 2) + 4 * n + (i & 3); }

struct Unit { int pm, pn, kt0, nt; };
struct Gemm { const bf16_t* A; const bf16_t* Bt; int M, N, K; };

struct StaticOrder {
    int nM, nN, nwg, G, c, ntk;
    __host__ __device__ void init(int M, int N, int G_, int c_, int ntk_) { nM = M / BM; nN = N / BM; nwg = nM * nN; G = G_; c = c_; ntk = ntk_; }
    __host__ __device__ bool next(int i, Unit& u) const {
        const long L = (long)i * G + c; if (L >= nwg) { u.pm = 0; u.pn = 0; u.kt0 = 0; u.nt = ntk; return false; }
        int wgid = (int)L; { const int q = nwg / NXCD, r = nwg % NXCD, xcd = wgid % NXCD, off = wgid / NXCD; wgid = (xcd < r ? xcd * (q + 1) : r * (q + 1) + (xcd - r) * q) + off; }
        const int nig = WGM * nN, gid = wgid / nig, fm = gid * WGM, gsz = (nM - fm) < WGM ? (nM - fm) : WGM;
        u.pm = fm + ((wgid % nig) % gsz); u.pn = (wgid % nig) / gsz; u.kt0 = 0; u.nt = ntk; return true;
    }
    __device__ __forceinline__ void a_ready(const Unit&) const {}
    __device__ __forceinline__ void done(const Unit&) const {}
};

__device__ __forceinline__ unsigned cvt_pk_bf16(float lo, float hi) { unsigned r; asm volatile("v_cvt_pk_bf16_f32 %0, %1, %2" : "=v"(r) : "v"(lo), "v"(hi)); return r; }
typedef float f32x2 __attribute__((ext_vector_type(2)));

struct ResOrder {
    StaticOrder lat; int rounds, nctx, nsplit, G, c;
    __host__ __device__ void init(int G_, int c_, int ntk, int nsplit_) { lat.init(32768, 1024, G_, c_, ntk); G = G_; c = c_; nsplit = nsplit_; nctx = 16 * nsplit_; rounds = (lat.nwg + G_ - 1) / G_; }
    __host__ __device__ bool next(int i, Unit& u) const {
        Unit v; v.pm = 0; v.pn = 0; v.kt0 = 0; v.nt = 2; bool ok;
        if (i < rounds) ok = lat.next(i, v);
        else { const int j = (i - rounds) * G + c; ok = j < nctx; const int jj = ok ? j : 0, ns = nsplit > 0 ? nsplit : 1; const int t = jj / ns, s = jj % ns; v.pm = 128 + (t >> 2); v.pn = t & 3; v.kt0 = 4 * s; v.nt = 4; }
        u.pm = v.pm; u.pn = v.pn; u.kt0 = v.kt0; u.nt = v.nt; return ok;
    }
    __device__ __forceinline__ void a_ready(const Unit&) const {}
    __device__ __forceinline__ void done(const Unit&) const {}
};
typedef unsigned u32x2 __attribute__((ext_vector_type(2)));
constexpr int E_DM = 1024, E_DFF = 2816, E_SEQ = 8192, E_MLAT = 32768, E_CTXL = 256, E_MODW = 9216;

struct EpiUp {
    static constexpr bool PERM = true, AFTER_DRAIN = false, PREFETCH = true;
    bf16_t* ACT; const float* R; const float* sW; PG8_LAS unsigned char* xl;
    __device__ __forceinline__ void prefetch(const Unit& u, int par, int wid, int lane) const {
        const int cond = u.pm < 128 ? (u.pm >> 5) : 4;
        const float* gp = wid < 4 ? R + (size_t)u.pm * BM + wid * 64 + lane : sW + cond * (2 * E_DFF) + u.pn * BM + (wid - 4) * 64 + lane;
        __builtin_amdgcn_global_load_lds((const unsigned*)gp, (PG8_LAS unsigned*)(xl + par * 2048 + wid * 256), 4, 0, 0);
    }
    __device__ __forceinline__ void operator()(const f32x4 (&acc)[2][2][4][2], const Unit& u, int wr, int wc, int fr_, int fq_, int par) const {
        int fr = fr_, fq = fq_; asm volatile("" : "+v"(fr), "+v"(fq));
        const int row0 = u.pm * BM + wr * 64 + fr, col0 = u.pn * 128 + wc * 32 + 8 * fq;
        const PG8_LAS float* rl = (const PG8_LAS float*)(xl + par * 2048) + wr * 64 + fr;
        const PG8_LAS float* sl = (const PG8_LAS float*)(xl + par * 2048 + 1024) + wc * 32 + 8 * fq;
        f32x4 sg[2], su[2];
#pragma unroll
        for (int n = 0; n < 2; ++n) { sg[n] = *(const PG8_LAS f32x4*)(sl + 4 * n); su[n] = *(const PG8_LAS f32x4*)(sl + HALF + 4 * n); }
#pragma unroll
        for (int ai = 0; ai < 2; ++ai) {
#pragma unroll
            for (int m = 0; m < 4; ++m) {
                bf16_t* rowp = ACT + (size_t)(row0 + ai * HALF + m * 16) * E_DFF + col0;
                const float r = rl[ai * HALF + m * 16];
                float a[8];
#pragma unroll
                for (int n = 0; n < 2; ++n)
#pragma unroll
                    for (int e = 0; e < 4; ++e) { const float g = r * acc[ai][0][m][n][e] + sg[n][e], up = r * acc[ai][1][m][n][e] + su[n][e];
                        a[n * 4 + e] = g * __builtin_amdgcn_rcpf(1.0f + __expf(-g)) * up; }
                u32x4 w; w.x = cvt_pk_bf16(a[0], a[1]); w.y = cvt_pk_bf16(a[2], a[3]); w.z = cvt_pk_bf16(a[4], a[5]); w.w = cvt_pk_bf16(a[6], a[7]);
                *(u32x4*)rowp = w;
            }
        }
    }
};

struct EpiRes {
    static constexpr bool PERM = false, AFTER_DRAIN = false, PREFETCH = false;
    const float* src_lat; float* dst_lat; float* dst_ctx; const float* modv; bf16_t* XGa; bf16_t* XGb; float* SS; const float* gnext; const float* sclnext; int flags;
    __device__ __forceinline__ void operator()(const f32x4 (&acc)[2][2][4][2], const Unit& u, int wr, int wc, int fr_, int fq_, int) const {
        int fr = fr_, fq = fq_; asm volatile("" : "+v"(fr), "+v"(fq));
        const bool lat = u.pm < 128; const int cond = lat ? (u.pm >> 5) : 4;
        const float coef0 = (flags & 4) ? 1.0f : 0.5f;
        const float* mv = modv + cond * E_MODW;
        const size_t tb = lat ? (size_t)u.pm * BM * E_DM : (size_t)(u.pm - 128) * BM * E_DM;
        const float* src = src_lat + tb; float* dst = (lat ? dst_lat : dst_ctx + (size_t)(u.kt0 >> 2) * (1024 * E_DM)) + tb;
        const int col0 = u.pn * BM + wc * 32 + 4 * fq;
        f32x4 g[2][2];
#pragma unroll
        for (int bj = 0; bj < 2; ++bj)
#pragma unroll
            for (int n = 0; n < 2; ++n) g[bj][n] = *(const f32x4*)(mv + col0 + bj * HALF + n * 16) * coef0;
        const bool emit = lat && (flags & 1) != 0; bf16_t* XG = (flags & 2) ? XGb : XGa;
        f32x4 gm[2][2];
        if (emit) {
#pragma unroll
            for (int bj = 0; bj < 2; ++bj)
#pragma unroll
                for (int n = 0; n < 2; ++n) gm[bj][n] = *(const f32x4*)(gnext + col0 + bj * HALF + n * 16) * (1.0f + *(const f32x4*)(sclnext + cond * E_MODW + col0 + bj * HALF + n * 16));
        }
#pragma unroll
        for (int ai = 0; ai < 2; ++ai)
#pragma unroll
            for (int m = 0; m < 4; ++m) { const size_t off = (size_t)(ai * HALF + wr * 64 + m * 16 + fr) * E_DM + col0; float ss = 0.f;
#pragma unroll
                for (int bj = 0; bj < 2; ++bj)
#pragma unroll
                    for (int n = 0; n < 2; ++n) {
                        if (lat) { const f32x4 s = *(const f32x4*)(src + off + bj * HALF + n * 16);
                            const f32x4 o = s + g[bj][n] * acc[ai][bj][m][n];
                            *(f32x4*)(dst + off + bj * HALF + n * 16) = o;
                            if (emit) { const f32x4 q = o * o; ss += (q[0] + q[1]) + (q[2] + q[3]); const f32x4 xg = o * gm[bj][n];
                                u32x2 w; w.x = cvt_pk_bf16(xg[0], xg[1]); w.y = cvt_pk_bf16(xg[2], xg[3]); *(u32x2*)(XG + tb + off + bj * HALF + n * 16) = w; } }
                        else *(f32x4*)(dst + off + bj * HALF + n * 16) = g[bj][n] * acc[ai][bj][m][n];
                    }
                if (emit) { ss += __shfl_xor(ss, 16); ss += __shfl_xor(ss, 32); if (fq == 0) SS[(size_t)(u.pm * BM + ai * HALF + wr * 64 + m * 16 + fr) * 16 + u.pn * 4 + wc] = ss; }
                if (m & 1) asm volatile("" ::: "memory");
            }
    }
};

struct EpiQKV {
    static constexpr bool PERM = false, AFTER_DRAIN = false, PREFETCH = true;
    bf16_t* Q; bf16_t* Kb; bf16_t* KC; bf16_t* VT; bf16_t* VTC; const float* qkg; const float* rope; const float* R; const float* sW; PG8_LAS unsigned char* xl;
    __device__ __forceinline__ void prefetch(const Unit& u, int par, int wid, int lane) const {
        const int cond = u.pm < 128 ? (u.pm >> 5) : 4;
        const float* gp = wid < 4 ? R + (size_t)u.pm * BM + wid * 64 + lane : sW + cond * (2 * E_DFF) + u.pn * BM + (wid - 4) * 64 + lane;
        __builtin_amdgcn_global_load_lds((const unsigned*)gp, (PG8_LAS unsigned*)(xl + par * 2048 + wid * 256), 4, 0, 0);
    }
    __device__ __forceinline__ void operator()(const f32x4 (&acc)[2][2][4][2], const Unit& u, int wr, int wc, int fr_, int fq_, int par) const {
        int fr = fr_, fq = fq_; asm volatile("" : "+v"(fr), "+v"(fq));
        const int head = u.pn * 4 + wc;
        const int type = head < 8 ? 0 : head < 16 ? 1 : head < 24 ? 2 : head < 32 ? 3 : head < 34 ? 4 : 5;
        const bool isv = (type == 3 || type == 5), lat = u.pm < 128;
        const PG8_LAS float* rl = (const PG8_LAS float*)(xl + par * 2048) + wr * 64 + fr;
        const PG8_LAS float* sl = (const PG8_LAS float*)(xl + par * 2048 + 1024) + wc * 32 + 4 * fq;
        f32x4 sw4[2][2];
#pragma unroll
        for (int bj = 0; bj < 2; ++bj)
#pragma unroll
            for (int n = 0; n < 2; ++n) sw4[bj][n] = *(const PG8_LAS f32x4*)(sl + bj * HALF + n * 16);
        if (!isv) {
            const int gi = type == 0 ? 0 : type == 2 ? 1 : type == 1 ? 2 : 3;
            const bool dorope = (type == 1 || type == 4) && lat;
            const float qs = type <= 1 ? 0.125f * 1.4426950408889634f : 1.0f;
            f32x4 g[2][2];
#pragma unroll
            for (int bj = 0; bj < 2; ++bj)
#pragma unroll
                for (int n = 0; n < 2; ++n) g[bj][n] = *(const f32x4*)(qkg + gi * 64 + 32 * bj + 16 * n + 4 * fq);
            const int kh = type == 2 ? head - 16 : 8 + head - 32;
#pragma unroll
            for (int ai = 0; ai < 2; ++ai) {
#pragma unroll
                for (int m = 0; m < 4; ++m) {
                    const int row = u.pm * BM + ai * HALF + wr * 64 + m * 16 + fr;
                    f32x4 v[2][2]; float ss = 0.f;
                    const float rr = rl[ai * HALF + m * 16];
#pragma unroll
                    for (int bj = 0; bj < 2; ++bj)
#pragma unroll
                        for (int n = 0; n < 2; ++n) { v[bj][n] = rr * acc[ai][bj][m][n] + sw4[bj][n]; const f32x4 q = v[bj][n] * v[bj][n]; ss += (q[0] + q[1]) + (q[2] + q[3]); }
                    ss += __shfl_xor(ss, 16); ss += __shfl_xor(ss, 32);
                    const float r = rsqrtf(ss * (1.0f / 64.0f) + 1e-6f);
#pragma unroll
                    for (int bj = 0; bj < 2; ++bj)
#pragma unroll
                        for (int n = 0; n < 2; ++n) v[bj][n] = v[bj][n] * r * g[bj][n];
                    if (dorope) {
                        const int t = row & (E_SEQ - 1);
#pragma unroll
                        for (int bj = 0; bj < 2; ++bj) { const int pos = bj ? 128 + (t & 63) : (t >> 6);
                            const f32x4 c4 = *(const f32x4*)(rope + pos * 16 + 4 * fq), s4 = *(const f32x4*)(rope + 3072 + pos * 16 + 4 * fq);
                            const f32x4 x1 = v[bj][0], x2 = v[bj][1]; v[bj][0] = x1 * c4 - x2 * s4; v[bj][1] = x2 * c4 + x1 * s4; }
                    }
                    bf16_t* rp;
                    if (type <= 1) rp = Q + (size_t)row * 1024 + head * 64 + 4 * fq;
                    else if (lat) { const int b = row >> 13, t = row & (E_SEQ - 1); rp = Kb + ((size_t)(b * 10 + kh) * 128 + (t >> 6)) * 4096 + ((t >> 5) & 1) * 2048 + (((fq >> 1) << 5) | (t & 31)) * 8 + (fq & 1) * 4; }
                    else { const int rc = row - E_MLAT, b = rc >> 8, t = rc & 255; rp = KC + ((size_t)(b * 10 + kh) * 4 + (t >> 6)) * 4096 + ((t >> 5) & 1) * 2048 + (((fq >> 1) << 5) | (t & 31)) * 8 + (fq & 1) * 4; }
                    const int cstep = type <= 1 ? 16 : 512;
#pragma unroll
                    for (int bj = 0; bj < 2; ++bj)
#pragma unroll
                        for (int n = 0; n < 2; ++n) { const f32x4 o = v[bj][n] * qs; u32x2 w; w.x = cvt_pk_bf16(o[0], o[1]); w.y = cvt_pk_bf16(o[2], o[3]);
                            *(u32x2*)(rp + (2 * bj + n) * cstep) = w; }
                }
            }
        } else {
            const int hv = type == 3 ? head - 24 : 8 + head - 34;
#pragma unroll
            for (int ai = 0; ai < 2; ++ai) {
#pragma unroll
                for (int m = 0; m < 4; ++m) {
                    const int row = u.pm * BM + ai * HALF + wr * 64 + m * 16 + fr;
                    const float rr = rl[ai * HALF + m * 16];
                    bf16_t* bp; constexpr size_t pitch = 8; int t;
                    if (lat) { const int b = row >> 13; t = row & (E_SEQ - 1); bp = VT + ((size_t)(b * 10 + hv) * 128 + (t >> 6)) * 4096; }
                    else { const int rc = row - E_MLAT, b = rc >> 8; t = rc & 255; bp = VTC + ((size_t)(b * 10 + hv) * 4 + (t >> 6)) * 4096; }
                    bp += ((t >> 4) & 3) * 512 + ((t >> 2) & 1) * 256 + ((t >> 3) & 1) * 4 + (t & 3);
#pragma unroll
                    for (int bj = 0; bj < 2; ++bj)
#pragma unroll
                        for (int n = 0; n < 2; ++n) { const f32x4 o = rr * acc[ai][bj][m][n] + sw4[bj][n]; const unsigned w0 = cvt_pk_bf16(o[0], o[1]), w1 = cvt_pk_bf16(o[2], o[3]);
                            bf16_t* dp = bp + bj * 2048 + (size_t)(16 * n + 4 * fq) * pitch;
                            dp[0] = (bf16_t)(w0 & 0xffffu); dp[pitch] = (bf16_t)(w0 >> 16); dp[2 * pitch] = (bf16_t)(w1 & 0xffffu); dp[3 * pitch] = (bf16_t)(w1 >> 16); }
                }
            }
        }
    }
};

template <class Epi, class Sched, bool ALIGN_EPI = false, bool SP2 = false>
__device__ __forceinline__ void gemm_phase(PG8_LAS unsigned char* lds, const Gemm g, const Sched& S, const Epi& E) {
    int tid_ = threadIdx.x; asm volatile("" : "+v"(tid_));
    const int tid = tid_, wid = __builtin_amdgcn_readfirstlane(tid >> 6), lane = tid & 63, wr = wid >> 2, wc = wid & 3, fr = lane & 15, fq = lane >> 4;
    const int K = g.K;
    unsigned voffA[2], voffB[2];
#pragma unroll
    for (int i = 0; i < 2; ++i) { int R, C; stage_rc(tid * 16 + i * 8192, R, C); const int Rb = Epi::PERM ? ((R & ~31) + perm32(R & 31)) : R;
        voffA[i] = (unsigned)(R * K + C) * 2u; voffB[i] = (unsigned)(Rb * K + C) * 2u; }
    const size_t kstep = (size_t)(BK * 2);
    const size_t hstep = (size_t)HALF * K * 2;
    const size_t tstep = 2 * hstep;
    const unsigned ldsw = (unsigned)wid * 1024u;
    const int aoff = lds_byte(wr * 64 + fr, fq * 8), boff = lds_byte(wc * 32 + fr, fq * 8);
#define PG8_SA(b, h) (((b) * 2 + (h)) * HTB)
#define PG8_SB(b, h) ((4 + (b) * 2 + (h)) * HTB)
#define PG8_STAGE(bufoff, gbase, voff) do { _Pragma("unroll") for (int _i = 0; _i < 2; ++_i) \
        __builtin_amdgcn_global_load_lds((const unsigned*)((const char*)(gbase) + (voff)[_i]), (PG8_LAS unsigned*)(lds + (bufoff) + ldsw + _i * 8192), 16, 0, 0); } while (0)
#define PG8_LDA(dst, b, h) do { _Pragma("unroll") for (int m = 0; m < 4; ++m) _Pragma("unroll") for (int k = 0; k < 2; ++k) dst[m][k] = *(const PG8_LAS bf16x8*)(lds + PG8_SA(b, h) + aoff + m * 2048 + k * 1024); } while (0)
#define PG8_LDB(dst, b, h) do { _Pragma("unroll") for (int n = 0; n < 2; ++n) _Pragma("unroll") for (int k = 0; k < 2; ++k) dst[n][k] = *(const PG8_LAS bf16x8*)(lds + PG8_SB(b, h) + boff + n * 2048 + k * 1024); } while (0)
#define PG8_MMA(ai, bj, At, Bt) do { __builtin_amdgcn_s_setprio(1); _Pragma("unroll") for (int m = 0; m < 4; ++m) _Pragma("unroll") for (int n = 0; n < 2; ++n) _Pragma("unroll") for (int k = 0; k < 2; ++k) \
        acc[ai][bj][m][n] = __builtin_amdgcn_mfma_f32_16x16x32_bf16(Bt[n][k], At[m][k], acc[ai][bj][m][n], 0, 0, 0); __builtin_amdgcn_s_setprio(0); } while (0)
#define PG8_WAIT_V(n) asm volatile("s_waitcnt vmcnt(" #n ")" ::: "memory")
#define PG8_WAIT_L(n) asm volatile("s_waitcnt lgkmcnt(" #n ")" ::: "memory")
#define PG8_BAR __builtin_amdgcn_s_barrier()
#define PG8_SCHED __builtin_amdgcn_sched_barrier(0)
    Unit cur{0, 0, 0, 2}, nxt{0, 0, 0, 2}; int ui = 0;
    if (!S.next(0, cur)) return;
    if constexpr (Epi::PREFETCH) E.prefetch(cur, 0, wid, lane);
    f32x4 acc[2][2][4][2];
#pragma unroll
    for (int a = 0; a < 2; ++a)
#pragma unroll
        for (int b = 0; b < 2; ++b)
#pragma unroll
            for (int m = 0; m < 4; ++m)
#pragma unroll
                for (int n = 0; n < 2; ++n) acc[a][b][m][n] = (f32x4){0.f, 0.f, 0.f, 0.f};
    bf16x8 At[4][2], B0[2][2], B1[2][2];
    const char* cA = (const char*)g.A + (size_t)cur.pm * tstep + (size_t)cur.kt0 * kstep; const char* cB = (const char*)g.Bt + (size_t)cur.pn * tstep + (size_t)cur.kt0 * kstep;
    S.a_ready(cur);
    if constexpr (SP2) {
        PG8_STAGE(PG8_SB(0, 0), cB, voffB); PG8_STAGE(PG8_SB(0, 1), cB + hstep, voffB); PG8_STAGE(PG8_SA(0, 0), cA, voffA); PG8_STAGE(PG8_SA(0, 1), cA + hstep, voffA);
        if (wr == 1) PG8_BAR;
        PG8_WAIT_V(2); PG8_BAR;
        PG8_STAGE(PG8_SB(1, 0), cB + kstep, voffB); PG8_STAGE(PG8_SA(1, 0), cA + kstep, voffA); PG8_STAGE(PG8_SB(1, 1), cB + hstep + kstep, voffB);
        PG8_WAIT_V(6); PG8_BAR;
    } else {
        PG8_STAGE(PG8_SB(0, 0), cB, voffB); PG8_STAGE(PG8_SA(0, 0), cA, voffA); PG8_STAGE(PG8_SB(0, 1), cB + hstep, voffB); PG8_STAGE(PG8_SA(0, 1), cA + hstep, voffA);
        if (wr == 1) PG8_BAR;
        PG8_WAIT_V(4); PG8_BAR;
        PG8_STAGE(PG8_SB(1, 0), cB + kstep, voffB); PG8_STAGE(PG8_SA(1, 0), cA + kstep, voffA); PG8_STAGE(PG8_SB(1, 1), cB + hstep + kstep, voffB);
        PG8_WAIT_V(6); PG8_BAR;
    }
    for (;;) {
        const bool has_next = S.next(ui + 1, nxt);
        const char* nA = has_next ? (const char*)g.A + (size_t)nxt.pm * tstep + (size_t)nxt.kt0 * kstep : cA; const char* nB = has_next ? (const char*)g.Bt + (size_t)nxt.pn * tstep + (size_t)nxt.kt0 * kstep : cB;
        const int nt = cur.nt;
        for (int t = 0; t < nt; t += 2) {
            const bool last = (t == nt - 2);
            const char* a1 = cA + (size_t)(t + 1) * kstep;
            const char* a2 = last ? nA : cA + (size_t)(t + 2) * kstep; const char* b2 = last ? nB : cB + (size_t)(t + 2) * kstep;
            const char* a3 = a2 + kstep; const char* b3 = b2 + kstep;
            if (last && has_next) S.a_ready(nxt);
            if constexpr (SP2) {
            PG8_LDB(B0, 0, 0); PG8_LDB(B1, 0, 1); PG8_SCHED; PG8_LDA(At, 0, 0); PG8_STAGE(PG8_SA(1, 1), a1 + hstep, voffA);
            PG8_WAIT_V(8); PG8_WAIT_L(0); PG8_BAR; PG8_MMA(0, 0, At, B0); PG8_MMA(0, 1, At, B1); PG8_BAR; PG8_SCHED;
            PG8_LDA(At, 0, 1); PG8_STAGE(PG8_SB(0, 0), b2, voffB); PG8_STAGE(PG8_SB(0, 1), b2 + hstep, voffB); PG8_STAGE(PG8_SA(0, 0), a2, voffA);
            PG8_WAIT_V(8); PG8_WAIT_L(0); PG8_BAR; PG8_MMA(1, 0, At, B0); PG8_MMA(1, 1, At, B1); PG8_BAR; PG8_SCHED;
            PG8_LDB(B0, 1, 0); PG8_LDB(B1, 1, 1); PG8_SCHED; PG8_LDA(At, 1, 0); PG8_STAGE(PG8_SA(0, 1), a2 + hstep, voffA);
            PG8_WAIT_V(8); PG8_WAIT_L(0); PG8_BAR; PG8_MMA(0, 0, At, B0); PG8_MMA(0, 1, At, B1); PG8_BAR; PG8_SCHED;
            PG8_LDA(At, 1, 1); PG8_STAGE(PG8_SB(1, 0), b3, voffB); PG8_STAGE(PG8_SB(1, 1), b3 + hstep, voffB); PG8_STAGE(PG8_SA(1, 0), a3, voffA);
            PG8_WAIT_V(8); PG8_WAIT_L(0); PG8_BAR; PG8_MMA(1, 0, At, B0); PG8_MMA(1, 1, At, B1); PG8_BAR; PG8_SCHED;
            } else {
            PG8_LDB(B0, 0, 0); PG8_SCHED; PG8_LDA(At, 0, 0); PG8_STAGE(PG8_SA(1, 1), a1 + hstep, voffA);
            PG8_WAIT_L(8); PG8_BAR; PG8_WAIT_L(0); PG8_MMA(0, 0, At, B0); PG8_BAR; PG8_SCHED;
            PG8_LDB(B1, 0, 1); PG8_STAGE(PG8_SB(0, 0), b2, voffB);
            PG8_BAR; PG8_WAIT_L(0); PG8_MMA(0, 1, At, B1); PG8_BAR;
            PG8_LDA(At, 0, 1); PG8_STAGE(PG8_SA(0, 0), a2, voffA);
            PG8_BAR; PG8_WAIT_L(0); PG8_MMA(1, 0, At, B0); PG8_BAR; PG8_SCHED;
            PG8_STAGE(PG8_SB(0, 1), b2 + hstep, voffB);
            PG8_WAIT_V(6); PG8_BAR; PG8_MMA(1, 1, At, B1); PG8_BAR;
            PG8_LDB(B0, 1, 0); PG8_SCHED; PG8_LDA(At, 1, 0); PG8_STAGE(PG8_SA(0, 1), a2 + hstep, voffA);
            PG8_WAIT_L(8); PG8_BAR; PG8_WAIT_L(0); PG8_MMA(0, 0, At, B0); PG8_BAR; PG8_SCHED;
            PG8_LDB(B1, 1, 1); PG8_STAGE(PG8_SB(1, 0), b3, voffB);
            PG8_BAR; PG8_WAIT_L(0); PG8_MMA(0, 1, At, B1); PG8_BAR;
            PG8_LDA(At, 1, 1); PG8_STAGE(PG8_SA(1, 0), a3, voffA);
            PG8_BAR; PG8_WAIT_L(0); PG8_MMA(1, 0, At, B0); PG8_BAR; PG8_SCHED;
            PG8_STAGE(PG8_SB(1, 1), b3 + hstep, voffB);
            PG8_WAIT_V(6); PG8_BAR; PG8_MMA(1, 1, At, B1); PG8_BAR;
            }
        }
        if constexpr (ALIGN_EPI) { if (wr == 0) PG8_BAR; }
        if constexpr (!Epi::AFTER_DRAIN) { E(acc, cur, wr, wc, fr, fq, ui & 1); S.done(cur); }
        if (!has_next) break;
#pragma unroll
        for (int a = 0; a < 2; ++a)
#pragma unroll
            for (int b = 0; b < 2; ++b)
#pragma unroll
                for (int m = 0; m < 4; ++m)
#pragma unroll
                    for (int n = 0; n < 2; ++n) acc[a][b][m][n] = (f32x4){0.f, 0.f, 0.f, 0.f};
        cur = nxt; cA = nA; cB = nB; ++ui;
        if constexpr (Epi::PREFETCH) E.prefetch(cur, ui & 1, wid, lane);
        if constexpr (ALIGN_EPI) { if (wr == 1) PG8_BAR; }
    }
    PG8_WAIT_V(0);
    if constexpr (!ALIGN_EPI) { if (wr == 0) PG8_BAR; }
    PG8_BAR;
    if constexpr (Epi::AFTER_DRAIN) { E.fused(acc, cur, wr, wc, fr, fq, lds, wid, lane); S.done(cur); }
#undef PG8_SA
#undef PG8_SB
#undef PG8_STAGE
#undef PG8_LDA
#undef PG8_LDB
#undef PG8_MMA
#undef PG8_WAIT_V
#undef PG8_WAIT_L
#undef PG8_BAR
#undef PG8_SCHED
}
}

#define LAS __attribute__((address_space(3)))
typedef unsigned short bf16;
typedef float f32x4 __attribute__((ext_vector_type(4)));
typedef float f32x16 __attribute__((ext_vector_type(16)));
typedef short bf16x8 __attribute__((ext_vector_type(8)));
typedef short s16x4 __attribute__((ext_vector_type(4)));
typedef unsigned v4u __attribute__((ext_vector_type(4)));
typedef unsigned v2u __attribute__((ext_vector_type(2)));

constexpr int DM = 1024, NB = 4, SEQ = 8192, DEPTH = 4, CTXL = 256, DFF = 2816, INW = 2304, MODW = 9216;
constexpr int MLAT = NB * SEQ, MCTX = NB * CTXL, MTOT = MLAT + MCTX;
constexpr float L2E = 1.4426950408889634f;
constexpr size_t MiB = 1u << 20;
constexpr size_t WS_BAR = 1 * MiB - 65536;
constexpr size_t WS_MOD = 0, WS_ROPE = 1 * MiB, WS_XC = 2 * MiB, WS_WUP = 8 * MiB, WS_WDN = 96 * MiB, WS_WIN = 140 * MiB, WS_WOUT = 158 * MiB,
                 WS_H = 166 * MiB, WS_Q = 232 * MiB, WS_K = 298 * MiB, WS_KC = 338 * MiB, WS_VT = 340 * MiB, WS_VTC = 380 * MiB, WS_ACT = 382 * MiB, WS_P = 564 * MiB, WS_SS = 608 * MiB, WS_SW = 612 * MiB, WS_R = 615 * MiB, WS_END = 616 * MiB;
constexpr int LDS_BYTES = 147456;
constexpr int NWAVES = 8;

struct Params {
    const float *x, *c, *ctx, *c_ctx, *w_ada, *b_ada, *norm_g, *w_up, *w_down, *w_in, *w_out, *qk_g, *rpb, *sink;
    float* out; unsigned char* ws;
};

__device__ __forceinline__ unsigned f2bf(float f) { unsigned u = __builtin_bit_cast(unsigned, f); return (u + 0x7fffu + ((u >> 16) & 1u)) >> 16; }
typedef __bf16 bf16x2_t __attribute__((ext_vector_type(2)));
typedef float f32x2_t __attribute__((ext_vector_type(2)));
__device__ __forceinline__ unsigned pk2(float lo, float hi) { return __builtin_bit_cast(unsigned, __builtin_convertvector((f32x2_t){lo, hi}, bf16x2_t)); }
__device__ __forceinline__ float wave_sum(float v) {
#pragma unroll
    for (int o = 1; o < 64; o <<= 1) v += __shfl_xor(v, o);
    return v;
}

__device__ __forceinline__ int opaque_tid() { int t = threadIdx.x; asm volatile("" : "+v"(t)); return t; }
#define PHASE_IDS const int tid = opaque_tid(), lane = tid & 63, wave = __builtin_amdgcn_readfirstlane(tid >> 6); (void)tid; (void)lane; (void)wave
__device__ __forceinline__ void p0_mod(const Params& p, LAS unsigned char* lds, float* MOD) {
    PHASE_IDS;
    LAS float* sc = (LAS float*)lds;
    LAS float* red = sc + 5 * 1024;
    for (int i = tid; i < 5 * 1024; i += 512) { const int b = i >> 10, k = i & 1023; const float v = b < 4 ? p.c[b * 1024 + k] : p.c_ctx[k]; sc[i] = v / (1.0f + __expf(-v)); }
    __syncthreads();
    for (int item = blockIdx.x; item < DEPTH * 72; item += gridDim.x) {
        const int l = item / 72, n0 = (item % 72) * 128;
        const float* W = p.w_ada + (size_t)l * DM * MODW + n0 + 2 * lane;
        float a[5][2];
#pragma unroll
        for (int b = 0; b < 5; ++b) { a[b][0] = 0.f; a[b][1] = 0.f; }
#pragma unroll 8
        for (int kk = 0; kk < 128; ++kk) { const int k = wave * 128 + kk; const float2 w = *(const float2*)(W + (size_t)k * MODW);
#pragma unroll
            for (int b = 0; b < 5; ++b) { const float s = sc[b * 1024 + k]; a[b][0] += s * w.x; a[b][1] += s * w.y; } }
#pragma unroll
        for (int b = 0; b < 5; ++b) { red[(wave * 5 + b) * 128 + 2 * lane] = a[b][0]; red[(wave * 5 + b) * 128 + 2 * lane + 1] = a[b][1]; }
        __syncthreads();
        for (int o = tid; o < 640; o += 512) { const int b = o >> 7, n = o & 127; float s = 0.f;
#pragma unroll
            for (int w = 0; w < 8; ++w) s += red[(w * 5 + b) * 128 + n];
            MOD[(size_t)(l * 5 + b) * MODW + n0 + n] = s + p.b_ada[l * MODW + n0 + n]; }
        __syncthreads();
    }
}

__device__ __forceinline__ float r6(float x) { unsigned u = __float_as_uint(x); u = (u + 0x1ffffu + ((u >> 18) & 1u)) & 0xfffc0000u; return __uint_as_float(u); }
__device__ __forceinline__ void p0_transpose_item(const float* W, int K, int N, bf16* WT, int k0, int n0, int r0, LAS float* scr, int lane) {
#pragma unroll 8
    for (int i = 0; i < 32; ++i) { const int kk = 2 * i + (lane >> 5); scr[kk * 33 + (lane & 31)] = W[(size_t)(k0 + kk) * N + n0 + (lane & 31)]; }
    asm volatile("s_waitcnt lgkmcnt(0)" ::: "memory");
    const int c = lane & 7;
#pragma unroll
    for (int j = 0; j < 4; ++j) { const int n = (lane >> 3) + 8 * j; const LAS float* s = scr + (8 * c) * 33 + n;
        v4u o; o.x = pk2(r6(s[0 * 33]), r6(s[1 * 33])); o.y = pk2(r6(s[2 * 33]), r6(s[3 * 33])); o.z = pk2(r6(s[4 * 33]), r6(s[5 * 33])); o.w = pk2(r6(s[6 * 33]), r6(s[7 * 33]));
        *(v4u*)(WT + (size_t)(r0 + n) * K + k0 + 8 * c) = o; }
    asm volatile("s_waitcnt lgkmcnt(0)" ::: "memory");
}
__device__ __forceinline__ void p0_weights(const Params& p, LAS unsigned char* lds, unsigned char* ws) {
    PHASE_IDS;
    LAS float* scr = (LAS float*)(lds + 65536 + wave * 8704);
    const int gw = blockIdx.x * NWAVES + wave, NGW = gridDim.x * NWAVES;
    constexpr int I_UP = 16 * 176, I_DN = 44 * 32, I_IN = 16 * 72, I_OUT = 16 * 32;
    constexpr int T_UP = 8 * I_UP, T_DN = 8 * I_DN, T_IN = 4 * I_IN, T_OUT = 4 * I_OUT;
    for (int it = gw; it < T_UP + T_DN + T_IN + T_OUT; it += NGW) {
        int r = it;
        if (r < T_UP) { const int mtx = r / I_UP, q = r % I_UP, kb = q / 176, nb = q % 176, n0 = nb * 32;
            const int j = n0 < DFF ? n0 : n0 - DFF; const int r0 = (j >> 7) * 256 + (n0 < DFF ? 0 : 128) + (j & 127);
            p0_transpose_item(p.w_up + (size_t)mtx * DM * 2 * DFF, DM, 2 * DFF, (bf16*)(ws + WS_WUP) + (size_t)mtx * 2 * DFF * DM, kb * 64, n0, r0, scr, lane); continue; }
        r -= T_UP;
        if (r < T_DN) { const int mtx = r / I_DN, q = r % I_DN, kb = q / 32, nb = q % 32;
            p0_transpose_item(p.w_down + (size_t)mtx * DFF * DM, DFF, DM, (bf16*)(ws + WS_WDN) + (size_t)mtx * DM * DFF, kb * 64, nb * 32, nb * 32, scr, lane); continue; }
        r -= T_DN;
        if (r < T_IN) { const int mtx = r / I_IN, q = r % I_IN, kb = q / 72, nb = q % 72, n0 = nb * 32;
            const int head = n0 >> 6, bj = (n0 >> 5) & 1; const int r0 = (head >> 2) * 256 + bj * 128 + (head & 3) * 32;
            p0_transpose_item(p.w_in + (size_t)mtx * DM * INW, DM, INW, (bf16*)(ws + WS_WIN) + (size_t)mtx * INW * DM, kb * 64, n0, r0, scr, lane); continue; }
        r -= T_IN;
        { const int mtx = r / I_OUT, q = r % I_OUT, kb = q / 32, nb = q % 32;
            p0_transpose_item(p.w_out + (size_t)mtx * DM * DM, DM, DM, (bf16*)(ws + WS_WOUT) + (size_t)mtx * DM * DM, kb * 64, nb * 32, nb * 32, scr, lane); }
    }
}

__device__ __forceinline__ void norm_phase(const float* xlat, const float* xctx, float* XC, const float* P, int npart, bf16* H, float* SS, const float* g, const float* modl, int jshift, int row_begin, int Mrows) {
    PHASE_IDS;
    const int gw = blockIdx.x * NWAVES + wave, NGW = gridDim.x * NWAVES;
    for (int row = row_begin + gw; row < Mrows; row += NGW) {
        const int cond = row < MLAT ? (row >> 13) : 4;
        const float* xr = row < MLAT ? xlat + (size_t)row * DM : xctx + (size_t)(row - MLAT) * DM;
        f32x4 v[4]; float s = 0.f;
#pragma unroll
        for (int j = 0; j < 4; ++j) v[j] = *((const f32x4*)xr + lane + 64 * j);
        if (row >= MLAT) {
            const float* pr = P + (size_t)(row - MLAT) * DM;
            for (int sp = 0; sp < npart; ++sp) {
#pragma unroll
                for (int j = 0; j < 4; ++j) v[j] += *((const f32x4*)(pr + (size_t)sp * MCTX * DM) + lane + 64 * j); }
#pragma unroll
            for (int j = 0; j < 4; ++j) *((f32x4*)(XC + (size_t)(row - MLAT) * DM) + lane + 64 * j) = v[j];
        }
#pragma unroll
        for (int j = 0; j < 4; ++j) { const f32x4 q = v[j] * v[j]; s += (q[0] + q[1]) + (q[2] + q[3]); }
        const float tot = wave_sum(s);
        if (lane == 0) SS[row] = rsqrtf(tot * (1.0f / DM) + 1e-6f);
        const float* sh = modl + (size_t)cond * MODW + jshift * DM; const float* scl = sh + DM;
        unsigned long long* o8 = (unsigned long long*)(H + (size_t)row * DM) + lane;
#pragma unroll
        for (int j = 0; j < 4; ++j) { const f32x4 gg = *((const f32x4*)g + lane + 64 * j), s4 = *((const f32x4*)scl + lane + 64 * j);
            const f32x4 o = v[j] * gg * (1.0f + s4);
            o8[64 * j] = (unsigned long long)pk2(o[0], o[1]) | ((unsigned long long)pk2(o[2], o[3]) << 32); }
    }
}

__device__ __forceinline__ void sw_phase(const unsigned char* ws, const float* MOD, float* SW) {
    PHASE_IDS;
    const int gw = blockIdx.x * NWAVES + wave, NGW = gridDim.x * NWAVES;
    for (int mtx = 0; mtx < 12; ++mtx) {
        const int l = mtx / 3, sub = mtx % 3, N = sub == 1 ? INW : 2 * DFF;
        const bf16* Bt = sub == 1 ? (const bf16*)(ws + WS_WIN) + (size_t)l * INW * DM : (const bf16*)(ws + WS_WUP) + (size_t)(l * 2 + (sub >> 1)) * 2 * DFF * DM;
        const float* sh = MOD + (size_t)l * 5 * MODW + 3 * sub * DM + lane * 16;
        f32x4 shv[5][4];
#pragma unroll
        for (int c = 0; c < 5; ++c)
#pragma unroll
            for (int j = 0; j < 4; ++j) shv[c][j] = *(const f32x4*)(sh + (size_t)c * MODW + 4 * j);
        for (int n = gw; n < N; n += NGW) {
            const v4u w0 = *(const v4u*)(Bt + (size_t)n * DM + lane * 16), w1 = *(const v4u*)(Bt + (size_t)n * DM + lane * 16 + 8);
            f32x4 wf[4];
            wf[0] = (f32x4){__uint_as_float(w0.x << 16), __uint_as_float(w0.x & 0xffff0000u), __uint_as_float(w0.y << 16), __uint_as_float(w0.y & 0xffff0000u)};
            wf[1] = (f32x4){__uint_as_float(w0.z << 16), __uint_as_float(w0.z & 0xffff0000u), __uint_as_float(w0.w << 16), __uint_as_float(w0.w & 0xffff0000u)};
            wf[2] = (f32x4){__uint_as_float(w1.x << 16), __uint_as_float(w1.x & 0xffff0000u), __uint_as_float(w1.y << 16), __uint_as_float(w1.y & 0xffff0000u)};
            wf[3] = (f32x4){__uint_as_float(w1.z << 16), __uint_as_float(w1.z & 0xffff0000u), __uint_as_float(w1.w << 16), __uint_as_float(w1.w & 0xffff0000u)};
            float d[5];
#pragma unroll
            for (int c = 0; c < 5; ++c) { f32x4 a = shv[c][0] * wf[0] + shv[c][1] * wf[1] + shv[c][2] * wf[2] + shv[c][3] * wf[3]; d[c] = wave_sum((a[0] + a[1]) + (a[2] + a[3])); }
            if (lane < 5) { const float v = lane == 0 ? d[0] : lane == 1 ? d[1] : lane == 2 ? d[2] : lane == 3 ? d[3] : d[4]; SW[((size_t)mtx * 5 + lane) * (2 * DFF) + n] = v; }
        }
    }
}

__device__ __forceinline__ void rfactor_phase(const float* SS, float* R) {
    PHASE_IDS;
    for (int row = blockIdx.x * 512 + tid; row < MLAT; row += gridDim.x * 512) {
        const f32x4* p = (const f32x4*)(SS + (size_t)row * 16); const f32x4 a = p[0], b = p[1], c = p[2], d = p[3];
        const float t = ((a[0] + a[1]) + (a[2] + a[3])) + ((b[0] + b[1]) + (b[2] + b[3])) + ((c[0] + c[1]) + (c[2] + c[3])) + ((d[0] + d[1]) + (d[2] + d[3]));
        R[row] = rsqrtf(t * (1.0f / DM) + 1e-6f);
    }
}

struct AttnBufs { const bf16* Q; const bf16* K; const bf16* KC; const bf16* VT; const bf16* VTC; bf16* O; const float* sink; };

template <int MASK, int QH>
__device__ __forceinline__ void attn_tile(bf16x8 (&kf)[2][4], const bf16x8 (&qf)[4], f32x16 (&ot)[2], float& l,
                                          const bf16* vt, const bf16* knext, int lane, int mp0, int mp1, const LAS float* tab, float negB, const unsigned (&mw)[2][8]) {
#define ATT_LIVE(kb, i) (MASK != 1 || (QH == 0 ? (32 * (kb) + 8 * ((i) >> 2) < 40) : (32 * (kb) + 8 * ((i) >> 2) >= 24)))
#define ATT_KS_LIVE(ks) (ATT_LIVE((ks) >> 1, 8 * ((ks) & 1)) || ATT_LIVE((ks) >> 1, 8 * ((ks) & 1) + 4))
    bf16x8 vfr[2][4];
#pragma unroll
    for (int db = 0; db < 2; ++db)
#pragma unroll
        for (int ks = 0; ks < 4; ++ks) if (ATT_KS_LIVE(ks)) vfr[db][ks] = *(const bf16x8*)(vt + ((db * 4 + ks) * 64 + lane) * 8);
    f32x16 st[2];
#pragma unroll
    for (int kb = 0; kb < 2; ++kb) {
#pragma unroll
        for (int i = 0; i < 16; ++i) st[kb][i] = negB;
#pragma unroll
        for (int kk = 0; kk < 4; ++kk) st[kb] = __builtin_amdgcn_mfma_f32_32x32x16_bf16(kf[kb][kk], qf[kk], st[kb], 0, 0, 0);
    }
#pragma unroll
    for (int kb = 0; kb < 2; ++kb)
#pragma unroll
        for (int kk = 0; kk < 4; ++kk) kf[kb][kk] = *(const bf16x8*)(knext + ((kb * 4 + kk) * 64 + lane) * 8);
    float ls = 0.f;
    bf16x8 pf[4];
#pragma unroll
    for (int kb = 0; kb < 2; ++kb)
#pragma unroll
        for (int hs = 0; hs < 2; ++hs) {
            if (!ATT_KS_LIVE(2 * kb + hs)) continue;
            float pv[8];
#pragma unroll
            for (int j = 0; j < 8; ++j) {
                const int i = 8 * hs + j, kc = 32 * kb + 8 * (i >> 2) + (i & 3);
                if (!ATT_LIVE(kb, i)) { pv[j] = 0.f; continue; }
                float s = st[kb][i];
                if (MASK == 1) s += tab[mp1 + kc];
                float pe = __builtin_amdgcn_exp2f(s);
                if (MASK == 2) pe = ((unsigned)(kc + mp0) <= 256u) ? pe : 0.f;
                pv[j] = pe; if (MASK != 1) ls += pe;
            }
            v4u w; w.x = pk2(pv[0], pv[1]); w.y = pk2(pv[2], pv[3]); w.z = pk2(pv[4], pv[5]); w.w = pk2(pv[6], pv[7]);
            if (MASK == 1) {
                unsigned wm[4] = {w.x, w.y, w.z, w.w};
#pragma unroll
                for (int t = 0; t < 4; ++t) { if (!ATT_LIVE(kb, 8 * hs + 2 * t)) { wm[t] = 0u; continue; }
                    wm[t] &= mw[kb][4 * hs + t];
                    ls += __uint_as_float(wm[t] << 16); ls += __uint_as_float(wm[t] & 0xffff0000u); }
                w.x = wm[0]; w.y = wm[1]; w.z = wm[2]; w.w = wm[3];
            }
            pf[2 * kb + hs] = __builtin_bit_cast(bf16x8, w);
        }
    l += ls;
#pragma unroll
    for (int db = 0; db < 2; ++db)
#pragma unroll
        for (int ks = 0; ks < 4; ++ks) if (ATT_KS_LIVE(ks)) ot[db] = __builtin_amdgcn_mfma_f32_32x32x16_bf16(vfr[db][ks], pf[ks], ot[db], 0, 0, 0);
#undef ATT_LIVE
#undef ATT_KS_LIVE
}

template <int KIND, int QH>
__device__ __forceinline__ void attn_unit(const AttnBufs& a, int u, int lane, const LAS float* rpbt, float bndA, float bndB) {
    const int half = lane >> 5, r32 = lane & 31;
    int b, head16, hv, qrow0; float l = 0.f, bound;
    int r = 0, r0 = 0, q0 = 0, h = 0; float sinkv = 0.f; bool has_sink = false;
    if (KIND == 0) { r = u & 127; h = (u >> 7) & 7; b = u >> 10; qrow0 = b * SEQ + r * 64 + 32 * QH; head16 = h; hv = h; bound = bndA;
        r0 = r - 4; r0 = r0 < 0 ? 0 : (r0 > 120 ? 120 : r0); }
    else if (KIND == 1) { const int qb = u & 255, hq = (u >> 8) & 7; b = u >> 11; q0 = 32 * qb; qrow0 = b * SEQ + q0; head16 = 8 + hq; const int kvh = hq >> 2; hv = 8 + kvh;
        sinkv = a.sink[hq]; has_sink = true; bound = fmaxf(bndB, sinkv); }
    else { const int qblk = u & 7; head16 = (u >> 3) & 15; b = u >> 7; qrow0 = MLAT + b * CTXL + 32 * qblk;
        if (head16 < 8) { hv = head16; bound = bndA; } else { const int kvh = (head16 - 8) >> 2; hv = 8 + kvh; sinkv = a.sink[head16 - 8]; has_sink = true; bound = fmaxf(bndB, sinkv); } }
    const float negB = -bound * L2E;
    if (has_sink) l = 0.5f * __builtin_amdgcn_exp2f(sinkv * L2E + negB);
    bf16x8 qf[4], kf[2][4];
    const bf16* qp = a.Q + (size_t)(qrow0 + r32) * DM + head16 * 64 + 8 * half;
#pragma unroll
    for (int kk = 0; kk < 4; ++kk) qf[kk] = *(const bf16x8*)(qp + 16 * kk);
    f32x16 ot[2]; unsigned mw[2][8];
#pragma unroll
    for (int db = 0; db < 2; ++db) {
#pragma unroll
        for (int i = 0; i < 16; ++i) ot[db][i] = 0.f;
#pragma unroll
        for (int i = 0; i < 8; ++i) mw[db][i] = 0u; }
    const bf16* kc0 = a.KC + (size_t)(b * 10 + hv) * 4 * 4096;
    const bf16* vc0 = a.VTC + (size_t)(b * 10 + hv) * 4 * 4096;
#pragma unroll
    for (int kb = 0; kb < 2; ++kb)
#pragma unroll
        for (int kk = 0; kk < 4; ++kk) kf[kb][kk] = *(const bf16x8*)(kc0 + ((kb * 4 + kk) * 64 + lane) * 8);
    const bf16* kl0 = a.K + (size_t)(b * 10 + hv) * 128 * 4096;
    const bf16* vl0 = a.VT + (size_t)(b * 10 + hv) * 128 * 4096;
    int ntl = 0, t0 = 0;
    if (KIND == 0) { ntl = 8; t0 = r0 * 64; }
    int ti0 = 0, nint = 0, tbA = 0, tbB = 0; bool hasA = false, hasB = false;
    if (KIND == 1) { const int lo = (q0 - 34) & ~63; int a0 = lo, a1 = lo + 192; if (a0 < 0) a0 = 0; if (a1 > SEQ) a1 = SEQ; ti0 = a0; nint = (a1 - a0) >> 6;
        tbA = lo - 64; hasA = tbA >= 0; tbB = lo + 192; hasB = tbB < SEQ; ntl = (hasA ? 1 : 0) + (hasB ? 1 : 0); t0 = hasA ? tbA : tbB; }
    const int n1 = 4 + nint;
#pragma unroll 1
    for (int j = 0; j < n1; ++j) {
        const int jn = j + 1;
        const bf16* kn = jn < 4 ? kc0 + jn * 4096 : (jn < n1 ? kl0 + (size_t)(ti0 + 64 * (jn - 4)) * 64 : (ntl > 0 ? kl0 + (size_t)t0 * 64 : kc0));
        const bf16* vt = j < 4 ? vc0 + j * 4096 : vl0 + (size_t)(ti0 + 64 * (j - 4)) * 64;
        attn_tile<0, 0>(kf, qf, ot, l, vt, kn, lane, 0, 0, rpbt, negB, mw);
    }
    if (KIND == 0) {
        const int c = QH * 32 + r32; int c0 = c - 8; c0 = c0 < 0 ? 0 : (c0 > 48 ? 48 : c0);
#pragma unroll
        for (int kb = 0; kb < 2; ++kb)
#pragma unroll
            for (int pp = 0; pp < 8; ++pp) { const int i = 2 * pp, kc = 32 * kb + 8 * (i >> 2) + (i & 3) + 4 * half - c0;
                mw[kb][pp] = ((unsigned)kc < 16u ? 0x0000ffffu : 0u) | ((unsigned)(kc + 1) < 16u ? 0xffff0000u : 0u); }
#pragma unroll 1
        for (int i = 0; i < 8; ++i) {
            const int tk = t0 + 64 * i; const bf16* kn = kl0 + (size_t)(i < 7 ? tk + 64 : tk) * 64;
            const int dr = r0 + i - r + 7;
            attn_tile<1, QH>(kf, qf, ot, l, vl0 + (size_t)tk * 64, kn, lane, 4 * half - c0, h * 640 + 64 + dr * 31 + 15 - c + 4 * half, rpbt, negB, mw);
        }
    }
    if (KIND == 1) {
        const int q = q0 + r32;
#pragma unroll 1
        for (int i = 0; i < ntl; ++i) {
            const int tk = (i == 0 && hasA) ? tbA : tbB; const bf16* kn = kl0 + (size_t)((i == 0 && hasA && hasB) ? tbB : tk) * 64;
            attn_tile<2, 0>(kf, qf, ot, l, vl0 + (size_t)tk * 64, kn, lane, tk + 4 * half - q + 128, 0, rpbt, negB, mw);
        }
    }
    l += __shfl_xor(l, 32);
    const float inv = 1.0f / l;
    bf16* op = a.O + (size_t)(qrow0 + r32) * DM + head16 * 64 + 4 * half;
#pragma unroll
    for (int db = 0; db < 2; ++db)
#pragma unroll
        for (int g = 0; g < 4; ++g) { v2u w; w.x = pk2(ot[db][4 * g] * inv, ot[db][4 * g + 1] * inv); w.y = pk2(ot[db][4 * g + 2] * inv, ot[db][4 * g + 3] * inv);
            *(v2u*)(op + 32 * db + 8 * g) = w; }
}

__device__ __forceinline__ float wave_max(float v) {
#pragma unroll
    for (int o = 1; o < 64; o <<= 1) v = fmaxf(v, __shfl_xor(v, o));
    return v;
}
__device__ __forceinline__ void attn_phase(const AttnBufs& a, const float* rpb_l, const float* qkg, bool with_ctx, LAS unsigned char* lds) {
    PHASE_IDS;
    LAS float* tab = (LAS float*)lds;
    LAS float* red = tab + 8 * 640;
    float bm = 0.f;
    for (int i = tid; i < 8 * 640; i += 512) { const int h = i / 640, o = i % 640 - 64; const float v = (o >= 0 && o < 465) ? rpb_l[h * 465 + o] : 0.f; tab[i] = v * L2E; bm = fmaxf(bm, fabsf(v)); }
    bm = wave_max(bm); if (lane == 0) red[wave] = bm;
    __syncthreads();
    bm = 0.f;
#pragma unroll
    for (int w = 0; w < 8; ++w) bm = fmaxf(bm, red[w]);
    const float gqa = wave_max(fabsf(qkg[lane])), gka = wave_max(fabsf(qkg[64 + lane])), gqb = wave_max(fabsf(qkg[128 + lane])), gkb = wave_max(fabsf(qkg[192 + lane]));
    const float bndA = 8.16f * gqa * gka + bm, bndB = 8.16f * gqb * gkb;
    const int gw = blockIdx.x * NWAVES + wave, NGW = gridDim.x * NWAVES;
    for (int u = gw; u < 4096; u += NGW) attn_unit<0, 0>(a, u, lane, tab, bndA, bndB);
    for (int u = gw; u < 4096; u += NGW) attn_unit<0, 1>(a, u, lane, tab, bndA, bndB);
    for (int u = gw; u < 8192; u += NGW) attn_unit<1, 0>(a, u, lane, tab, bndA, bndB);
    if (with_ctx) for (int u = gw; u < 512; u += NGW) attn_unit<2, 0>(a, u, lane, tab, bndA, bndB);
}

#define XB_TMO      128
#define XB_XCNT(j)  (256  + 64 * (j))
#define XB_XSUB(j)  (1280 + 64 * (j))
#define XB_XGEN(j)  (2304 + 64 * (j))
#define XB_TOP      3328
#define XB_TOPGEN   3392
#define XCD_BAR_WORDS 3456
#define XB_SPIN_CAP (1u << 18)

__device__ __forceinline__ unsigned xb_ld(unsigned* p)              { return __hip_atomic_load(p, __ATOMIC_RELAXED, __HIP_MEMORY_SCOPE_AGENT); }
__device__ __forceinline__ unsigned xb_add(unsigned* p, unsigned v) { return __hip_atomic_fetch_add(p, v, __ATOMIC_RELAXED, __HIP_MEMORY_SCOPE_AGENT); }
__device__ __forceinline__ unsigned xb_xcc_id() { return (unsigned)__builtin_amdgcn_s_getreg((3 << 11) | 20) & 0xFu; }
#define XB_SPIN(cond, bar) do { unsigned _sp = 0; while (cond) { __builtin_amdgcn_s_sleep(1); \
    if ((++_sp & 255u) == 0u) { if (xb_ld(&(bar)[XB_TMO])) break; if (_sp > XB_SPIN_CAP) { atomicAdd(&(bar)[XB_TMO], 1u); break; } } } } while (0)

struct XcdBarrier {
    unsigned* bar; unsigned x;
    volatile LAS unsigned* st;
};

__device__ __forceinline__ XcdBarrier xcd_barrier_post(unsigned* bar, volatile LAS unsigned* st) {
    XcdBarrier b; b.bar = bar; b.x = xb_xcc_id(); b.st = st;
    if (threadIdx.x == 0) (void)xb_add(&bar[XB_XCNT(b.x)], 1u);
    return b;
}
__device__ __forceinline__ void xcd_barrier_complete(unsigned* bar, unsigned x, unsigned& nloc, unsigned& nx) {
    const unsigned G = gridDim.x * gridDim.y * gridDim.z;
    unsigned sum, cnt, mine, sp = 0u;
    for (;;) {
        sum = 0u; cnt = 0u; mine = 0u;
#pragma unroll
        for (unsigned j = 0; j < 16; ++j) { const unsigned c = xb_ld(&bar[XB_XCNT(j)]); sum += c; cnt += (c > 0u) ? 1u : 0u; mine = (j == x) ? c : mine; }
        if (sum == G) break;
        __builtin_amdgcn_s_sleep(1);
        if ((++sp & 255u) == 0u) { if (xb_ld(&bar[XB_TMO])) break; if (sp > XB_SPIN_CAP) { atomicAdd(&bar[XB_TMO], 1u); break; } }
    }
    nloc = mine > 0u ? mine : 1u; nx = cnt > 0u ? cnt : 1u;
}

__device__ __forceinline__ void xcd_barrier(const XcdBarrier& b) {
    asm volatile("s_waitcnt vmcnt(0)" ::: "memory");
    __syncthreads();
    if (threadIdx.x == 0) {
        unsigned* bar = b.bar;
        __builtin_amdgcn_s_waitcnt(0);
        unsigned nloc = b.st[0], nx = b.st[1];
        if (nloc == 0u) { xcd_barrier_complete(bar, b.x, nloc, nx); b.st[0] = nloc; b.st[1] = nx; }
        const unsigned old = xb_add(&bar[XB_XSUB(b.x)], 1u);
        const unsigned gen = old / nloc;
        if (old + 1u == (gen + 1u) * nloc) {
            __builtin_amdgcn_fence(__ATOMIC_RELEASE, "agent");
            asm volatile("s_waitcnt vmcnt(0)" ::: "memory");
            const unsigned og = xb_add(&bar[XB_TOP], 1u);
            const unsigned tg = og / nx;
            if (og + 1u == (tg + 1u) * nx) xb_add(&bar[XB_TOPGEN], 1u);
            else XB_SPIN(xb_ld(&bar[XB_TOPGEN]) == tg, bar);
            __builtin_amdgcn_fence(__ATOMIC_ACQUIRE, "agent");
            xb_add(&bar[XB_XGEN(b.x)], 1u);
            asm volatile("s_waitcnt vmcnt(0)" ::: "memory");
        } else {
            XB_SPIN(xb_ld(&bar[XB_XGEN(b.x)]) == gen, bar);
            __builtin_amdgcn_fence(__ATOMIC_ACQUIRE, "agent");
            asm volatile("s_waitcnt vmcnt(0)" ::: "memory");
        }
    }
    __syncthreads();
}

__global__ void __launch_bounds__(NWAVES * 64, 2) fwd_mega(Params p) {
    extern __shared__ __attribute__((aligned(16))) unsigned char lds_raw[];
    LAS unsigned char* lds = (LAS unsigned char*)lds_raw;
    cg::grid_group grid = cg::this_grid();
    unsigned char* ws = p.ws;
    float* SS = (float*)(ws + WS_SS); float* SW = (float*)(ws + WS_SW); float* RF = (float*)(ws + WS_R);
    float* MOD = (float*)(ws + WS_MOD); float* ROPE = (float*)(ws + WS_ROPE); float* XC = (float*)(ws + WS_XC);
    bf16* H = (bf16*)(ws + WS_H); bf16* Qb = (bf16*)(ws + WS_Q); bf16* Kb = (bf16*)(ws + WS_K); bf16* KC = (bf16*)(ws + WS_KC); bf16* VT = (bf16*)(ws + WS_VT); bf16* VTC = (bf16*)(ws + WS_VTC);
    bf16* ACT = (bf16*)(ws + WS_ACT);
    const int G = gridDim.x;

    volatile LAS unsigned* bst = (volatile LAS unsigned*)(lds + LDS_BYTES - 64);
    { PHASE_IDS; if (tid < 2) bst[tid] = 0u;
      if (blockIdx.x == 0) for (int i = tid; i < XCD_BAR_WORDS; i += 512) ((unsigned*)(ws + WS_BAR))[i] = 0u; }
    if (blockIdx.x == 0) {
        PHASE_IDS;
        for (int i = tid; i < 3072; i += 512) { const int pos = i >> 4, f = i & 15; const float pv = (float)(pos < 128 ? pos : pos - 128);
            const float invf = powf(10000.0f, -(float)(2 * f) / 32.0f); const float ang = pv * invf; ROPE[i] = cosf(ang); ROPE[3072 + i] = sinf(ang); }
    }
#ifndef NO_P0
    p0_mod(p, lds, MOD);
    p0_weights(p, lds, ws);
#endif
    grid.sync();
    const XcdBarrier xbar = xcd_barrier_post((unsigned*)(ws + WS_BAR), bst);
#define GSYNC() xcd_barrier(xbar)
    sw_phase(ws, MOD, SW);
    norm_phase(p.x, p.ctx, XC, (const float*)(ws + WS_P), 0, H, RF, p.norm_g, MOD, 0, 0, MTOT);
    GSYNC();

    for (int l = 0; l < DEPTH; ++l) {
        const bool last = (l == DEPTH - 1);
        const float* modl = MOD + (size_t)l * 5 * MODW;
        for (int sub = 0; sub < 3; ++sub) {
            const bool first = (l == 0 && sub == 0);
            const float* xlat = first ? p.x : p.out; const float* xctx = first ? p.ctx : XC;
            const int Mrows = (last && sub == 2) ? MLAT : MTOT;
            bf16* Hs = sub == 2 ? Qb : H;
            if (!first) {
                rfactor_phase(SS, RF);
                if (Mrows > MLAT) norm_phase(xlat, xctx, XC, (const float*)(ws + WS_P), sub == 2 ? 4 : 11, Hs, RF, p.norm_g + (size_t)(l * 3 + sub) * DM, modl, 3 * sub, MLAT, Mrows);
                GSYNC();
            }
            if (sub != 1) {
                const int s = sub >> 1;
                pg8::Gemm g{Hs, (const bf16*)(ws + WS_WUP) + (size_t)(l * 2 + s) * 2 * DFF * DM, Mrows, 2 * DFF, DM};
                pg8::StaticOrder S; S.init(Mrows, 2 * DFF, G, (int)blockIdx.x, DM / 64);
                pg8::EpiUp E{ACT, RF, SW + (size_t)(l * 3 + sub) * 5 * 2 * DFF, lds + 131072};
#ifndef NO_UP
                pg8::gemm_phase<pg8::EpiUp, pg8::StaticOrder, true, true>(lds, g, S, E);
#endif
                GSYNC();
            } else {
                pg8::Gemm g{H, (const bf16*)(ws + WS_WIN) + (size_t)l * INW * DM, MTOT, INW, DM};
                pg8::StaticOrder S; S.init(MTOT, INW, G, (int)blockIdx.x, DM / 64);
                pg8::EpiQKV E{Qb, Kb, KC, VT, VTC, p.qk_g + (size_t)l * 4 * 64, ROPE, RF, SW + (size_t)(l * 3 + 1) * 5 * 2 * DFF, lds + 131072};
#ifndef NO_QKV
                pg8::gemm_phase<pg8::EpiQKV, pg8::StaticOrder, true, true>(lds, g, S, E);
#endif
                GSYNC();
                AttnBufs ab{Qb, Kb, KC, VT, VTC, H, p.sink + l * 8};
#ifndef NO_ATTN
                attn_phase(ab, p.rpb + (size_t)l * 8 * 465, p.qk_g + (size_t)l * 4 * 64, !last, lds);
#endif
                GSYNC();
            }
            {
                const int Mr = (last && sub >= 1) ? MLAT : MTOT;
                const bf16* A = sub == 1 ? H : ACT; const int K = sub == 1 ? DM : DFF;
                const bf16* Bt = sub == 1 ? (const bf16*)(ws + WS_WOUT) + (size_t)l * DM * DM : (const bf16*)(ws + WS_WDN) + (size_t)(l * 2 + (sub >> 1)) * DM * DFF;
                pg8::Gemm g{A, Bt, Mr, DM, K};
                pg8::ResOrder S; S.init(G, (int)blockIdx.x, K / 64, Mr == MTOT ? K / 256 : 0);
                const int nl = sub == 2 ? l + 1 : l, ns = sub == 2 ? 0 : sub + 1; const bool has_next = nl < DEPTH;
                const int nlc = has_next ? nl : l;
                pg8::EpiRes E;
                E.src_lat = xlat; E.dst_lat = p.out; E.dst_ctx = (float*)(ws + WS_P); E.modv = modl + (3 * sub + 2) * DM;
                E.XGa = H; E.XGb = Qb; E.SS = SS; E.gnext = p.norm_g + (size_t)(nlc * 3 + ns) * DM; E.sclnext = MOD + (size_t)nlc * 5 * MODW + (3 * ns + 1) * DM;
                E.flags = (has_next ? 1 : 0) | (ns == 2 ? 2 : 0) | (sub == 1 ? 4 : 0);
#ifndef NO_RES
                pg8::gemm_phase<pg8::EpiRes, pg8::ResOrder, true, true>(lds, g, S, E);
#endif
                GSYNC();
            }
        }
    }
}

extern "C" void kernel_launch(void* const* d_in, const int* in_sizes, int n_in, void* d_out, int out_size, void* d_ws, size_t ws_size, hipStream_t stream) {
    static int grid = 0;
    if (grid == 0) {
        if (n_in != 14 || out_size != MLAT * DM || ws_size < WS_END) { fprintf(stderr, "kernel_launch: unexpected shapes (n_in %d out %d ws %zu)\n", n_in, out_size, ws_size); grid = -1; return; }
        int dev = 0, cus = 0, per_cu = 0;
        hipGetDevice(&dev); hipDeviceGetAttribute(&cus, hipDeviceAttributeMultiprocessorCount, dev);
        if (hipFuncSetAttribute((const void*)fwd_mega, hipFuncAttributeMaxDynamicSharedMemorySize, LDS_BYTES) != hipSuccess) { fprintf(stderr, "kernel_launch: hipFuncSetAttribute failed\n"); grid = -1; return; }
        if (hipOccupancyMaxActiveBlocksPerMultiprocessor(&per_cu, (const void*)fwd_mega, NWAVES * 64, LDS_BYTES) != hipSuccess || per_cu < 1) { fprintf(stderr, "kernel_launch: occupancy query says %d\n", per_cu); per_cu = 1; }
        (void)hipGetLastError();
        grid = cus * per_cu;
    }
    if (grid < 0) return;
    Params p{};
    p.x = (const float*)d_in[0]; p.c = (const float*)d_in[1]; p.ctx = (const float*)d_in[2]; p.c_ctx = (const float*)d_in[3]; p.w_ada = (const float*)d_in[4]; p.b_ada = (const float*)d_in[5];
    p.norm_g = (const float*)d_in[6]; p.w_up = (const float*)d_in[7]; p.w_down = (const float*)d_in[8]; p.w_in = (const float*)d_in[9]; p.w_out = (const float*)d_in[10];
    p.qk_g = (const float*)d_in[11]; p.rpb = (const float*)d_in[12]; p.sink = (const float*)d_in[13];
    p.out = (float*)d_out; p.ws = (unsigned char*)d_ws;
    void* args[] = {&p};
    hipError_t e = hipLaunchCooperativeKernel((const void*)fwd_mega, dim3(grid), dim3(NWAVES * 64), args, LDS_BYTES, stream);
    if (e != hipSuccess) fprintf(stderr, "kernel_launch: cooperative launch failed: %s (grid %d)\n", hipGetErrorString(e), grid);
}
```
